# Optimizing an MI355X kernel written in HIP

```python
import jax, jax.numpy as jnp
from jax import lax
import numpy as np

D_MODEL = 1024
BATCH = 2
SEQ = 8192
DEPTH = 1

CTX_LEN = 256
GRID_W = 64
D_RNN = 1024
RNN_HEADS = 4
RNN_HEAD_DIM = D_RNN // RNN_HEADS
CONV_W = 4
LRU_C = 8.0
D_POOL = 1024
POOL_WINDOWS = (2, 4, 8, 16)
POOL_GROUP = D_POOL // len(POOL_WINDOWS)
IN_COLS = 2 * D_RNN + D_POOL + 2 * D_MODEL
N_EXPERTS = 32
TOP_K = 4
D_FF = 1024
SWIGLU_LIMIT = 7.0
SWIGLU_ALPHA = 1.702
EPS = 1e-6

kernel_name = 'hybrid_rglru_pool_moe_block'


def rmsnorm(x, g):
    xf = x.astype(jnp.float32)
    y = xf * lax.rsqrt(jnp.mean(xf * xf, axis=-1, keepdims=True) + EPS)
    return (y * g.astype(jnp.float32)).astype(x.dtype)


def modulate(u, shift, scale):
    return u * (1 + scale) + shift


def dwconv_centred(x, w, b):
    left = CONV_W // 2
    y = lax.conv_general_dilated(x, w[:, None, :], window_strides=(1,),
                                 padding=[(left, CONV_W - 1 - left)],
                                 dimension_numbers=('NWC', 'WIO', 'NWC'),
                                 feature_group_count=x.shape[-1])
    return y + b


def lru_coeffs(xc, wa, ba, wx, bx, lam):
    bsz, t = xc.shape[:2]
    xh = xc.reshape(bsz, t, RNN_HEADS, RNN_HEAD_DIM)
    r = jax.nn.sigmoid(jnp.einsum('bthi,hij->bthj', xh, wa).reshape(bsz, t, D_RNN) + ba)
    i = jax.nn.sigmoid(jnp.einsum('bthi,hij->bthj', xh, wx).reshape(bsz, t, D_RNN) + bx)
    log_a = -LRU_C * r.astype(jnp.float32) * jax.nn.softplus(-lam.astype(jnp.float32))
    a = jnp.exp(log_a)
    mult = jnp.sqrt(-jnp.expm1(2.0 * log_a))
    b = mult * (i * xc).astype(jnp.float32)
    return a, b


def _combine(left, right):
    a_l, b_l = left
    a_r, b_r = right
    return a_l * a_r, a_r * b_l + b_r


def linear_scan(a, b, h0):
    if h0 is not None:
        b = b.at[:, 0].add(a[:, 0] * h0)
    _, h = lax.associative_scan(_combine, (a, b), axis=1)
    return h


def recurrent_states(x_rnn, conv_w, conv_b, wa, ba, wx, bx, lam, h0_f, h0_b):
    xc = dwconv_centred(x_rnn, conv_w, conv_b)
    a_f, b_f = lru_coeffs(xc, wa[0], ba[0], wx[0], bx[0], lam[0])
    a_b, b_b = lru_coeffs(xc, wa[1], ba[1], wx[1], bx[1], lam[1])
    h_f = linear_scan(a_f, b_f, h0_f)
    h_b = jnp.flip(linear_scan(jnp.flip(a_b, 1), jnp.flip(b_b, 1), h0_b), 1)
    return h_f, h_b


def pool_mixer(xp, n_rows, w_grp, scale):
    bsz, t, _ = xp.shape
    line = t // n_rows
    xf = xp.reshape(bsz, n_rows, line, D_POOL).astype(jnp.float32)
    cs = jnp.pad(jnp.cumsum(xf, axis=2), ((0, 0), (0, 0), (1, 0), (0, 0)))
    pos = jnp.arange(line)
    diffs = []
    for gi, w in enumerate(POOL_WINDOWS):
        lo = jnp.clip(pos - w // 2, 0, line)
        hi = jnp.clip(pos + w - w // 2, 0, line)
        seg = cs[..., gi * POOL_GROUP:(gi + 1) * POOL_GROUP]
        mean = (jnp.take(seg, hi, axis=2) - jnp.take(seg, lo, axis=2)) / (hi - lo).astype(jnp.float32)[:, None]
        diffs.append(mean - xf[..., gi * POOL_GROUP:(gi + 1) * POOL_GROUP])
    d = jnp.stack(diffs, axis=-2).astype(xp.dtype)
    y = jnp.einsum('brlgi,gij->brlgj', d, w_grp)
    return y.reshape(bsz, t, D_POOL) * scale


def mixer(u, n_rows, h0_f, h0_b, w_in, conv_w, conv_b, wa, ba, wx, bx, lam,
          pool_w, pool_scale, w_rnn_proj, w_pool_proj, w_out):
    proj = u @ w_in
    x_rnn, g_rnn, x_pool, m_rnn, m_pool = jnp.split(
        proj, [D_RNN, 2 * D_RNN, 2 * D_RNN + D_POOL, 2 * D_RNN + D_POOL + D_MODEL], axis=-1)
    h_f, h_b = recurrent_states(x_rnn, conv_w, conv_b, wa, ba, wx, bx, lam, h0_f, h0_b)
    y_rnn = (h_f + h_b).astype(u.dtype) * jax.nn.gelu(g_rnn)
    y_pool = pool_mixer(x_pool, n_rows, pool_w, pool_scale)
    merged = jax.nn.sigmoid(m_rnn) * (y_rnn @ w_rnn_proj) + jax.nn.sigmoid(m_pool) * (y_pool @ w_pool_proj)
    return merged @ w_out, h_f, h_b


def moe(h, w_r, b_r, w1, b1, w2, b2):
    logits = (h @ w_r + b_r).astype(jnp.float32)
    top_v, top_i = lax.top_k(logits, TOP_K)
    top_w = jax.nn.softmax(top_v, axis=-1)
    comb = jnp.einsum('nk,nke->ne', top_w, jax.nn.one_hot(top_i, N_EXPERTS, dtype=jnp.float32)).astype(h.dtype)
    out = jnp.zeros_like(h)
    for e in range(N_EXPERTS):
        z = h @ w1[e] + b1[e]
        glu = jnp.minimum(z[:, :D_FF], SWIGLU_LIMIT)
        lin = jnp.clip(z[:, D_FF:], -SWIGLU_LIMIT, SWIGLU_LIMIT)
        act = glu * jax.nn.sigmoid(SWIGLU_ALPHA * glu) * (lin + 1)
        out = out + comb[:, e:e + 1] * (act @ w2[e] + b2[e])
    return out


def setup_inputs(seed: int = 0) -> dict:
    key = jax.random.key(seed)
    ks = iter(jax.random.split(key, 40))
    f32 = jnp.float32
    L = DEPTH

    def nrm(shape, scale):
        return jax.random.normal(next(ks), shape, f32) * scale

    def gain(shape):
        return 1.0 + 0.05 * jax.random.normal(next(ks), shape, f32)

    u = jax.random.uniform(next(ks), (L, 2, D_RNN), f32, minval=0.9, maxval=0.999)
    a0 = u ** (1.0 / LRU_C)
    lam = jnp.log(a0) - jnp.log1p(-a0)
    return {
        'x': nrm((BATCH, SEQ, D_MODEL), 1.0),
        'c': nrm((BATCH, D_MODEL), 1.0),
        'ctx': nrm((BATCH, CTX_LEN, D_MODEL), 1.0),
        'c_ctx': nrm((D_MODEL,), 1.0),
        'w_mod': nrm((L, D_MODEL, 6 * D_MODEL), 0.5 * D_MODEL ** -0.5),
        'b_mod': nrm((L, 6 * D_MODEL), 0.02),
        'norm_pre_mix': gain((L, D_MODEL)),
        'norm_post_mix': gain((L, D_MODEL)),
        'norm_pre_ffn': gain((L, D_MODEL)),
        'norm_post_ffn': gain((L, D_MODEL)),
        'w_in': nrm((L, D_MODEL, IN_COLS), D_MODEL ** -0.5),
        'conv_w': nrm((L, CONV_W, D_RNN), CONV_W ** -0.5),
        'conv_b': nrm((L, D_RNN), 0.02),
        'lru_wa': nrm((L, 2, RNN_HEADS, RNN_HEAD_DIM, RNN_HEAD_DIM), RNN_HEAD_DIM ** -0.5),
        'lru_ba': nrm((L, 2, D_RNN), 0.02),
        'lru_wx': nrm((L, 2, RNN_HEADS, RNN_HEAD_DIM, RNN_HEAD_DIM), RNN_HEAD_DIM ** -0.5),
        'lru_bx': nrm((L, 2, D_RNN), 0.02),
        'lru_lambda': lam,
        'pool_w': nrm((L, len(POOL_WINDOWS), POOL_GROUP, POOL_GROUP), POOL_GROUP ** -0.5),
        'pool_scale': 1.0 + 0.1 * jax.random.normal(next(ks), (L, D_POOL), f32),
        'w_rnn_proj': nrm((L, D_RNN, D_MODEL), D_RNN ** -0.5),
        'w_pool_proj': nrm((L, D_POOL, D_MODEL), D_POOL ** -0.5),
        'w_out': nrm((L, D_MODEL, D_MODEL), D_MODEL ** -0.5),
        'router_w': nrm((L, D_MODEL, N_EXPERTS), D_MODEL ** -0.5),
        'router_b': nrm((L, N_EXPERTS), 0.01),
        'exp_w1': nrm((L, N_EXPERTS, D_MODEL, 2 * D_FF), D_MODEL ** -0.5),
        'exp_b1': nrm((L, N_EXPERTS, 2 * D_FF), 0.02),
        'exp_w2': nrm((L, N_EXPERTS, D_FF, D_MODEL), D_FF ** -0.5),
        'exp_b2': nrm((L, N_EXPERTS, D_MODEL), 0.02),
    }


def reference(x, c, ctx, c_ctx, w_mod, b_mod, norm_pre_mix, norm_post_mix, norm_pre_ffn,
              norm_post_ffn, w_in, conv_w, conv_b, lru_wa, lru_ba, lru_wx, lru_bx, lru_lambda,
              pool_w, pool_scale, w_rnn_proj, w_pool_proj, w_out, router_w, router_b,
              exp_w1, exp_b1, exp_w2, exp_b2):
    bsz, seq, d = x.shape
    rows = seq // GRID_W
    for l in range(DEPTH):
        last = l == DEPTH - 1
        mod_lat = (jax.nn.silu(c) @ w_mod[l] + b_mod[l])[:, None, :]
        mod_ctx = jax.nn.silu(c_ctx) @ w_mod[l] + b_mod[l]
        sh1, sc1, g1, sh2, sc2, g2 = jnp.split(mod_lat, 6, axis=-1)
        csh1, csc1, cg1, csh2, csc2, cg2 = jnp.split(mod_ctx, 6, axis=-1)
        mix_w = (w_in[l], conv_w[l], conv_b[l], lru_wa[l], lru_ba[l], lru_wx[l], lru_bx[l],
                 lru_lambda[l], pool_w[l], pool_scale[l], w_rnn_proj[l], w_pool_proj[l], w_out[l])

        u_ctx = modulate(rmsnorm(ctx, norm_pre_mix[l]), csh1, csc1)
        if last:
            hc_f, hc_b = recurrent_states(u_ctx @ w_in[l][:, :D_RNN], conv_w[l], conv_b[l],
                                          lru_wa[l], lru_ba[l], lru_wx[l], lru_bx[l],
                                          lru_lambda[l], None, None)
        else:
            m_ctx, hc_f, hc_b = mixer(u_ctx, 1, None, None, *mix_w)

        u_lat = modulate(rmsnorm(x, norm_pre_mix[l]), sh1, sc1)
        m_lat, _, _ = mixer(u_lat, rows, hc_f[:, -1], hc_b[:, 0], *mix_w)
        x = x + g1 * rmsnorm(m_lat, norm_post_mix[l])
        if not last:
            ctx = ctx + cg1 * rmsnorm(m_ctx, norm_post_mix[l])

        moe_w = (router_w[l], router_b[l], exp_w1[l], exp_b1[l], exp_w2[l], exp_b2[l])
        v_lat = modulate(rmsnorm(x, norm_pre_ffn[l]), sh2, sc2).reshape(-1, d)
        if last:
            f_lat = moe(v_lat, *moe_w).reshape(bsz, seq, d)
        else:
            v_ctx = modulate(rmsnorm(ctx, norm_pre_ffn[l]), csh2, csc2).reshape(-1, d)
            f_all = moe(jnp.concatenate([v_lat, v_ctx], axis=0), *moe_w)
            f_lat = f_all[:bsz * seq].reshape(bsz, seq, d)
            f_ctx = f_all[bsz * seq:].reshape(ctx.shape)
            ctx = ctx + cg2 * rmsnorm(f_ctx, norm_post_ffn[l])
        x = x + g2 * rmsnorm(f_lat, norm_post_ffn[l])
    return x
```

```cpp
#include <hip/hip_runtime.h>
#include <cstdio>
#include <cstdint>

#ifndef MK_MULTI
#define MK_MULTI 0
#endif

#define GAS __attribute__((address_space(1)))
#define LAS __attribute__((address_space(3)))
typedef unsigned short bf16;
typedef float f32x4 __attribute__((ext_vector_type(4)));
typedef float f32x2 __attribute__((ext_vector_type(2)));
typedef unsigned u32x4 __attribute__((ext_vector_type(4)));
typedef unsigned u32x2 __attribute__((ext_vector_type(2)));
typedef short bf16x8 __attribute__((ext_vector_type(8)));
typedef float f32x16 __attribute__((ext_vector_type(16)));


constexpr int D = 1024, SEQ = 8192, NB = 2, ML = NB * SEQ  , CTXL = 256, MC = NB * CTXL  , MT = ML + MC  ;
constexpr int INC = 5120, NE = 32, DFF = 1024;
constexpr int NSUB_L = ML / 64  , NSUB_C = MC / 64  , NSUB = NSUB_L + NSUB_C;
constexpr int MAXTILES = 288, NPAIR = ML * 4;
constexpr float EPS = 1e-6f;
constexpr float LOG2E = 1.4426950408889634f;
constexpr float W8SCALE = 64.0f, ACT8SCALE = 4.0f, O8SCALE = 16.0f, O8INV = 1.0f / 16.0f;
constexpr int SC_ONE = 0x7f7f7f7f, SC_W8 = 0x79797979  , SC_ACT8 = 0x7d7d7d7d  ;

constexpr size_t MiB = 1u << 20;
constexpr size_t WS_CTL = 0, CTL_ZERO_BYTES = 64 * 1024;
constexpr size_t WS_MOD = 1 * MiB;
constexpr size_t WS_SP2 = 1 * MiB + 128 * 1024;
constexpr size_t WS_WRT = 2 * MiB;
constexpr size_t WS_PAIR_E = 3 * MiB, WS_PAIR_W = WS_PAIR_E + 256 * 1024, WS_PAIR_POS = WS_PAIR_W + 256 * 1024, WS_PAIR_SLOT = WS_PAIR_POS + 256 * 1024;
constexpr size_t WS_AGG = 4 * MiB;
constexpr size_t WS_CARRY = 9 * MiB;
constexpr size_t WS_WIN = 12 * MiB;
constexpr size_t WS_WG = 22 * MiB;
constexpr size_t WS_WP = 30 * MiB;
constexpr size_t WS_WPROJ = 31 * MiB;
constexpr size_t WS_WOUT = 35 * MiB;
constexpr size_t WS_W1T = 40 * MiB;
constexpr size_t WS_W2T = 168 * MiB;
constexpr size_t WS_U = 232 * MiB;
constexpr size_t WS_PROJ = 265 * MiB;
constexpr size_t WS_XC = 430 * MiB;
constexpr size_t WS_DP = 463 * MiB;
constexpr size_t WS_LAF = 495 * MiB, WS_BF = 528 * MiB, WS_LAB = 561 * MiB, WS_BB = 594 * MiB;
constexpr size_t WS_YY = 627 * MiB;
constexpr size_t WS_MERGED = 691 * MiB;
constexpr size_t WS_MLAT = 723 * MiB;
constexpr size_t WS_VB = 787 * MiB;
constexpr size_t WS_X1 = 819 * MiB;
constexpr size_t WS_TOKL = 883 * MiB;
constexpr size_t WS_END = 885 * MiB;
constexpr size_t WS_APERM = 232 * MiB;
constexpr size_t WS_ACT = 376 * MiB;
static_assert(WS_APERM + (size_t)MAXTILES * 256 * 1024 * 2 <= WS_ACT && WS_ACT + (size_t)MAXTILES * 256 * 1024 * 2 <= WS_YY, "moe overlay");
constexpr int CW_BAR = 1024;
constexpr int CW_MODFLAG = 6144;
constexpr int CW_TILEQ = 6208;
constexpr int CW_GCNT = 8192;

constexpr int RING_BYTES = 131072;
constexpr int LDS_UP = 132096;
constexpr int LDS_MISC = LDS_UP;
constexpr int LDS_TAB = LDS_UP + 1024;
constexpr int LDS_CNT = LDS_UP + 4096;
constexpr int LDS_LGT = LDS_UP + 8192;
constexpr int LDS_BYTES = 147456;
static_assert(LDS_LGT + 32 * 33 * 4 <= LDS_BYTES, "lds map");

__device__ __forceinline__ float blo(unsigned w) { return __uint_as_float(w << 16); }
__device__ __forceinline__ float bhi(unsigned w) { return __uint_as_float(w & 0xffff0000u); }
__device__ __forceinline__ float bf2f(bf16 h) { return __uint_as_float(((unsigned)h) << 16); }
__device__ __forceinline__ unsigned cvt_pk_bf16(float lo, float hi) { unsigned r; asm volatile("v_cvt_pk_bf16_f32 %0, %1, %2" : "=v"(r) : "v"(lo), "v"(hi)); return r; }
__device__ __forceinline__ float fexp2(float x) { return __builtin_amdgcn_exp2f(x); }
__device__ __forceinline__ float frcp(float x) { return __builtin_amdgcn_rcpf(x); }
__device__ __forceinline__ float sigmoidf_(float x) { return frcp(1.0f + fexp2(-LOG2E * x)); }
__device__ __forceinline__ float gelu_tanh_(float x) { const float t = x * (1.0f + 0.044715f * x * x); return x * frcp(1.0f + fexp2(-2.0f * 0.7978845608028654f * LOG2E * t)); }
template <int CTRL, int ROWMASK> __device__ __forceinline__ float dpp_mov0(float v) { return __builtin_bit_cast(float, __builtin_amdgcn_update_dpp(0, __builtin_bit_cast(int, v), CTRL, ROWMASK, 0xF, false)); }
__device__ __forceinline__ float wave_sum(float v) {
    v += dpp_mov0<0xB1, 0xF>(v);
    v += dpp_mov0<0x4E, 0xF>(v);
    v += dpp_mov0<0x141, 0xF>(v);
    v += dpp_mov0<0x140, 0xF>(v);
    v += dpp_mov0<0x142, 0xA>(v);
    v += dpp_mov0<0x143, 0xC>(v);
    return __builtin_bit_cast(float, __builtin_amdgcn_readlane(__builtin_bit_cast(int, v), 63));
}
#define LDS_WAIT() asm volatile("s_waitcnt lgkmcnt(0)" ::: "memory")
#define VM_WAIT() asm volatile("s_waitcnt vmcnt(0)" ::: "memory")

namespace pg8 {
constexpr int BM = 256, BK = 64, HALF = 128, HTB = HALF * BK * 2, STAGE_BYTES = 8 * HTB, NXCD = 8, WGM = 4;
__host__ __device__ __forceinline__ int lds_byte(int r, int c) { const int st = (r >> 4) * 2 + (c >> 5), rr = r & 15, cc = c & 31, ob = rr * 64 + cc * 2; return st * 1024 + (ob ^ (((ob >> 9) & 1) << 5)); }
__host__ __device__ __forceinline__ void stage_rc(int b, int& R, int& C) { const int st = b / 1024, sb = b % 1024, swz = sb ^ (((sb >> 9) & 1) << 5); R = (st >> 1) * 16 + swz / 64; C = (st & 1) * 32 + (swz % 64) / 2; }
__host__ __device__ __forceinline__ int perm32(int rho) { const int n = rho >> 4, i = rho & 15; return 8 * (i >> 2) + 4 * n + (i & 3); }

struct Unit { size_t aoff, boff; int pm, pn, aux; };
struct Gemm { const bf16* A; const bf16* Bt; int lda, ldb, K; };

__host__ __device__ __forceinline__ void tile_order(int L, int nM, int nN, int& pm, int& pn) {
    const int nwg = nM * nN; int wgid = L; { const int q = nwg / NXCD, r = nwg % NXCD, xcd = wgid % NXCD, off = wgid / NXCD; wgid = (xcd < r ? xcd * (q + 1) : r * (q + 1) + (xcd - r) * q) + off; }
    const int nig = WGM * nN, gid = wgid / nig, fm = gid * WGM, gsz = (nM - fm) < WGM ? (nM - fm) : WGM;
    pm = fm + ((wgid % nig) % gsz); pn = (wgid % nig) / gsz;
}

template <class Epi, class Sched, bool ALIGN_EPI = true>
__device__ __forceinline__ void gemm_phase(LAS unsigned char* lds, const Gemm g, const Sched& S, const Epi& E) {
    const int tid = threadIdx.x, wid = __builtin_amdgcn_readfirstlane(tid >> 6), lane = tid & 63, wr = wid >> 2, wc = wid & 3, fr = lane & 15, fq = lane >> 4;
    const int K = g.K, nt = K / BK;
    unsigned voffA[2], voffB[2];
#pragma unroll
    for (int i = 0; i < 2; ++i) { int R, C; stage_rc(tid * 16 + i * 8192, R, C); const int Rb = Epi::PERM ? ((R & ~31) + perm32(R & 31)) : R;
        voffA[i] = (unsigned)(R * g.lda + C) * 2u; voffB[i] = (unsigned)(Rb * g.ldb + C) * 2u; }
    const size_t kstep = (size_t)(BK * 2);
    const size_t hstepA = (size_t)HALF * g.lda * 2, hstepB = (size_t)HALF * g.ldb * 2;
    const unsigned ldsw = (unsigned)wid * 1024u;
    const int aoff = lds_byte(wr * 64 + fr, fq * 8), boff = lds_byte(wc * 32 + fr, fq * 8);
#define PG8_SA(b, h) (((b) * 2 + (h)) * HTB)
#define PG8_SB(b, h) ((4 + (b) * 2 + (h)) * HTB)
#define PG8_STAGE(bufoff, gbase, voff) do { _Pragma("unroll") for (int _i = 0; _i < 2; ++_i) \
        __builtin_amdgcn_global_load_lds((const unsigned*)((const char*)(gbase) + (voff)[_i]), (LAS unsigned*)(lds + (bufoff) + ldsw + _i * 8192), 16, 0, 0); } while (0)
#define PG8_LDA(dst, b, h) do { _Pragma("unroll") for (int m = 0; m < 4; ++m) _Pragma("unroll") for (int k = 0; k < 2; ++k) dst[m][k] = *(const LAS bf16x8*)(lds + PG8_SA(b, h) + aoff + m * 2048 + k * 1024); } while (0)
#define PG8_LDB(dst, b, h) do { _Pragma("unroll") for (int n = 0; n < 2; ++n) _Pragma("unroll") for (int k = 0; k < 2; ++k) dst[n][k] = *(const LAS bf16x8*)(lds + PG8_SB(b, h) + boff + n * 2048 + k * 1024); } while (0)
#define PG8_MMA(ai, bj, At, Bt) do { __builtin_amdgcn_s_setprio(1); _Pragma("unroll") for (int m = 0; m < 4; ++m) _Pragma("unroll") for (int n = 0; n < 2; ++n) _Pragma("unroll") for (int k = 0; k < 2; ++k) \
        acc[ai][bj][m][n] = __builtin_amdgcn_mfma_f32_16x16x32_bf16(Bt[n][k], At[m][k], acc[ai][bj][m][n], 0, 0, 0); __builtin_amdgcn_s_setprio(0); } while (0)
#define PG8_WAIT_V(n) asm volatile("s_waitcnt vmcnt(" #n ")" ::: "memory")
#define PG8_WAIT_L(n) asm volatile("s_waitcnt lgkmcnt(" #n ")" ::: "memory")
#define PG8_BAR __builtin_amdgcn_s_barrier()
#define PG8_SCHED __builtin_amdgcn_sched_barrier(0)
    Unit cur, nxt; int ui = 0;
    if (!S.next(0, cur)) return;
    f32x4 acc[2][2][4][2];
#pragma unroll
    for (int a = 0; a < 2; ++a)
#pragma unroll
        for (int b = 0; b < 2; ++b)
#pragma unroll
            for (int m = 0; m < 4; ++m)
#pragma unroll
                for (int n = 0; n < 2; ++n) acc[a][b][m][n] = (f32x4){0.f, 0.f, 0.f, 0.f};
    bf16x8 At[4][2], B0[2][2], B1[2][2];
    const char* cA = (const char*)g.A + cur.aoff; const char* cB = (const char*)g.Bt + cur.boff;
    PG8_STAGE(PG8_SB(0, 0), cB, voffB); PG8_STAGE(PG8_SB(0, 1), cB + hstepB, voffB); PG8_STAGE(PG8_SA(0, 0), cA, voffA); PG8_STAGE(PG8_SA(0, 1), cA + hstepA, voffA);
    if (wr == 1) PG8_BAR;
    PG8_WAIT_V(2); PG8_BAR;
    PG8_STAGE(PG8_SB(1, 0), cB + kstep, voffB); PG8_STAGE(PG8_SA(1, 0), cA + kstep, voffA); PG8_STAGE(PG8_SB(1, 1), cB + hstepB + kstep, voffB);
    PG8_WAIT_V(6); PG8_BAR;
    for (;;) {
        const bool has_next = S.next(ui + 1, nxt);
        const char* nA = has_next ? (const char*)g.A + nxt.aoff : cA; const char* nB = has_next ? (const char*)g.Bt + nxt.boff : cB;
#pragma nounroll
        for (int t = 0; t < nt; t += 2) {
            const bool last = (t == nt - 2);
            const char* a1 = cA + (size_t)(t + 1) * kstep;
            const char* a2 = last ? nA : cA + (size_t)(t + 2) * kstep; const char* b2 = last ? nB : cB + (size_t)(t + 2) * kstep;
            const char* a3 = a2 + kstep; const char* b3 = b2 + kstep;
            PG8_LDB(B0, 0, 0); PG8_LDB(B1, 0, 1); PG8_SCHED; PG8_LDA(At, 0, 0); PG8_STAGE(PG8_SA(1, 1), a1 + hstepA, voffA);
            PG8_WAIT_V(8); PG8_WAIT_L(0); PG8_BAR; PG8_MMA(0, 0, At, B0); PG8_MMA(0, 1, At, B1); PG8_BAR; PG8_SCHED;
            PG8_LDA(At, 0, 1); PG8_STAGE(PG8_SB(0, 0), b2, voffB); PG8_STAGE(PG8_SB(0, 1), b2 + hstepB, voffB); PG8_STAGE(PG8_SA(0, 0), a2, voffA);
            PG8_WAIT_V(8); PG8_WAIT_L(0); PG8_BAR; PG8_MMA(1, 0, At, B0); PG8_MMA(1, 1, At, B1); PG8_BAR; PG8_SCHED;
            PG8_LDB(B0, 1, 0); PG8_LDB(B1, 1, 1); PG8_SCHED; PG8_LDA(At, 1, 0); PG8_STAGE(PG8_SA(0, 1), a2 + hstepA, voffA);
            PG8_WAIT_V(8); PG8_WAIT_L(0); PG8_BAR; PG8_MMA(0, 0, At, B0); PG8_MMA(0, 1, At, B1); PG8_BAR; PG8_SCHED;
            PG8_LDA(At, 1, 1); PG8_STAGE(PG8_SB(1, 0), b3, voffB); PG8_STAGE(PG8_SB(1, 1), b3 + hstepB, voffB); PG8_STAGE(PG8_SA(1, 0), a3, voffA);
            PG8_WAIT_V(8); PG8_WAIT_L(0); PG8_BAR; PG8_MMA(1, 0, At, B0); PG8_MMA(1, 1, At, B1); PG8_BAR; PG8_SCHED;
        }
        if constexpr (ALIGN_EPI) { if (wr == 0) PG8_BAR; }
        E(acc, cur, wr, wc, fr, fq);
        if (!has_next) break;
#pragma unroll
        for (int a = 0; a < 2; ++a)
#pragma unroll
            for (int b = 0; b < 2; ++b)
#pragma unroll
                for (int m = 0; m < 4; ++m)
#pragma unroll
                    for (int n = 0; n < 2; ++n) acc[a][b][m][n] = (f32x4){0.f, 0.f, 0.f, 0.f};
        cur = nxt; cA = nA; cB = nB; ++ui;
        if constexpr (ALIGN_EPI) { if (wr == 1) PG8_BAR; }
    }
    PG8_WAIT_V(0);
    if constexpr (!ALIGN_EPI) { if (wr == 0) PG8_BAR; }
    PG8_BAR;
#undef PG8_SA
#undef PG8_SB
#undef PG8_STAGE
#undef PG8_LDA
#undef PG8_LDB
#undef PG8_MMA
#undef PG8_WAIT_V
#undef PG8_WAIT_L
#undef PG8_BAR
#undef PG8_SCHED
}
__host__ __device__ __forceinline__ int lds_byte8(int r, int cb) { const int st = (r >> 4) * 2 + (cb >> 6), rr = r & 15, ob = rr * 64 + (cb & 63); return st * 1024 + (ob ^ (((ob >> 9) & 1) << 4)); }
__host__ __device__ __forceinline__ void stage_rc8(int b, int& R, int& Cb) { const int st = b / 1024, sb = b % 1024, swz = sb ^ (((sb >> 9) & 1) << 4); R = (st >> 1) * 16 + swz / 64; Cb = (st & 1) * 64 + (swz % 64); }
typedef int i32x4 __attribute__((ext_vector_type(4)));
typedef int i32x8 __attribute__((ext_vector_type(8)));
template <class Epi, class Sched, bool GATHER = false, bool ALIGN_EPI = true>
__device__ __forceinline__ void gemm_phase8(LAS unsigned char* lds, const Gemm g, const Sched& S, const Epi& E, const int scaleA, const int scaleB, const int* __restrict__ rowlist = nullptr) {
    const int tid = threadIdx.x, wid = __builtin_amdgcn_readfirstlane(tid >> 6), lane = tid & 63, wr = wid >> 2, wc = wid & 3, fr = lane & 15, fq = lane >> 4;
    const int K = g.K, nt = K / 128;
    unsigned voffA[2], voffB[2], gC[2]; int gR[2];
#pragma unroll
    for (int i = 0; i < 2; ++i) { int R, C; stage_rc8(tid * 16 + i * 8192, R, C); const int Rb = Epi::PERM ? ((R & ~31) + perm32(R & 31)) : R;
        voffA[i] = (unsigned)(R * g.lda + C); voffB[i] = (unsigned)(Rb * g.ldb + C); gR[i] = R; gC[i] = (unsigned)C; }
    const size_t kstep = (size_t)128;
    const size_t hstepA = (size_t)HALF * g.lda, hstepB = (size_t)HALF * g.ldb;
    const unsigned ldsw = (unsigned)wid * 1024u;
    const int aoff0 = lds_byte8(wr * 64 + fr, fq * 32), aoff1 = lds_byte8(wr * 64 + fr, fq * 32 + 16), boff0 = lds_byte8(wc * 32 + fr, fq * 32), boff1 = lds_byte8(wc * 32 + fr, fq * 32 + 16);
#define PG8_SA(b, h) (((b) * 2 + (h)) * HTB)
#define PG8_SB(b, h) ((4 + (b) * 2 + (h)) * HTB)
#define PG8_STAGE(bufoff, gbase, voff) do { _Pragma("unroll") for (int _i = 0; _i < 2; ++_i) \
        __builtin_amdgcn_global_load_lds((const unsigned*)((const char*)(gbase) + (voff)[_i]), (LAS unsigned*)(lds + (bufoff) + ldsw + _i * 8192), 16, 0, 0); } while (0)
#define PG8_LDA(dst, b, h) do { _Pragma("unroll") for (int m = 0; m < 4; ++m) { dst[m].lo = *(const LAS i32x4*)(lds + PG8_SA(b, h) + aoff0 + m * 2048); dst[m].hi = *(const LAS i32x4*)(lds + PG8_SA(b, h) + aoff1 + m * 2048); } } while (0)
#define PG8_LDB(dst, b, h) do { _Pragma("unroll") for (int n = 0; n < 2; ++n) { dst[n].lo = *(const LAS i32x4*)(lds + PG8_SB(b, h) + boff0 + n * 2048); dst[n].hi = *(const LAS i32x4*)(lds + PG8_SB(b, h) + boff1 + n * 2048); } } while (0)
#define PG8_MMA(ai, bj, At, Bt) do { __builtin_amdgcn_s_setprio(1); _Pragma("unroll") for (int m = 0; m < 4; ++m) _Pragma("unroll") for (int n = 0; n < 2; ++n) \
        asm volatile("v_mfma_scale_f32_16x16x128_f8f6f4 %0, %1, %2, %0, %3, %4 op_sel_hi:[0,0,0]" : "+v"(acc[ai][bj][m][n]) : "v"(Bt[n]), "v"(At[m]), "v"(scaleB), "v"(scaleA)); __builtin_amdgcn_s_setprio(0); } while (0)
#define PG8_WAIT_V(n) asm volatile("s_waitcnt vmcnt(" #n ")" ::: "memory")
#define PG8_WAIT_L(n) asm volatile("s_waitcnt lgkmcnt(" #n ")" ::: "memory")
#define PG8_BAR __builtin_amdgcn_s_barrier()
#define PG8_SCHED __builtin_amdgcn_sched_barrier(0)
    unsigned vC[2][2], vN[2][2]; int ixn[2][2];
#define PG8_IDX_ISSUE(u_) do { if constexpr (GATHER) { const int nv_ = (int)((u_).aoff >> 32); const int* lp_ = rowlist + (unsigned)((u_).aoff); \
        _Pragma("unroll") for (int h_ = 0; h_ < 2; ++h_) _Pragma("unroll") for (int i_ = 0; i_ < 2; ++i_) { int rr_ = h_ * 128 + gR[i_]; rr_ = rr_ < nv_ ? rr_ : nv_ - 1; \
            asm volatile("global_load_dword %0, %1, off" : "=v"(ixn[h_][i_]) : "v"(lp_ + rr_) : "memory"); } } } while (0)
#define PG8_IDX_USE() do { if constexpr (GATHER) { asm volatile("" : "+v"(ixn[0][0]), "+v"(ixn[0][1]), "+v"(ixn[1][0]), "+v"(ixn[1][1])); \
        _Pragma("unroll") for (int h_ = 0; h_ < 2; ++h_) _Pragma("unroll") for (int i_ = 0; i_ < 2; ++i_) vN[h_][i_] = (unsigned)ixn[h_][i_] * (unsigned)g.lda + gC[i_]; } } while (0)
#define PG8_STAGE_A(bufoff, kptr, h, useN) do { if constexpr (GATHER) { _Pragma("unroll") for (int _i = 0; _i < 2; ++_i) { const unsigned vo_ = (useN) ? vN[h][_i] : vC[h][_i]; \
        __builtin_amdgcn_global_load_lds((const unsigned*)((const char*)(kptr) + vo_), (LAS unsigned*)(lds + (bufoff) + ldsw + _i * 8192), 16, 0, 0); } } \
        else { PG8_STAGE(bufoff, (const char*)(kptr) + (h) * hstepA, voffA); } } while (0)
    Unit cur, nxt; int ui = 0;
    if (!S.next(0, cur)) return;
    f32x4 acc[2][2][4][2];
#pragma unroll
    for (int a = 0; a < 2; ++a)
#pragma unroll
        for (int b = 0; b < 2; ++b)
#pragma unroll
            for (int m = 0; m < 4; ++m)
#pragma unroll
                for (int n = 0; n < 2; ++n) acc[a][b][m][n] = (f32x4){0.f, 0.f, 0.f, 0.f};
    i32x8 At[4], B0[2], B1[2];
    const char* cA = GATHER ? (const char*)g.A : (const char*)g.A + cur.aoff; const char* cB = (const char*)g.Bt + cur.boff;
    if constexpr (GATHER) { PG8_IDX_ISSUE(cur); PG8_WAIT_V(0); PG8_IDX_USE();
#pragma unroll
        for (int h_ = 0; h_ < 2; ++h_)
#pragma unroll
            for (int i_ = 0; i_ < 2; ++i_) vC[h_][i_] = vN[h_][i_]; }
    PG8_STAGE(PG8_SB(0, 0), cB, voffB); PG8_STAGE(PG8_SB(0, 1), cB + hstepB, voffB); PG8_STAGE_A(PG8_SA(0, 0), cA, 0, false); PG8_STAGE_A(PG8_SA(0, 1), cA, 1, false);
    if (wr == 1) PG8_BAR;
    PG8_WAIT_V(2); PG8_BAR;
    PG8_STAGE(PG8_SB(1, 0), cB + kstep, voffB); PG8_STAGE_A(PG8_SA(1, 0), cA + kstep, 0, false); PG8_STAGE(PG8_SB(1, 1), cB + hstepB + kstep, voffB);
    PG8_WAIT_V(6); PG8_BAR;
    for (;;) {
        const bool has_next = S.next(ui + 1, nxt);
        const char* nA = GATHER ? (const char*)g.A : (has_next ? (const char*)g.A + nxt.aoff : cA); const char* nB = has_next ? (const char*)g.Bt + nxt.boff : cB;
        if (has_next) PG8_IDX_ISSUE(nxt);
#pragma nounroll
        for (int t = 0; t < nt; t += 2) {
            const bool last = (t == nt - 2);
            const char* a1 = cA + (size_t)(t + 1) * kstep;
            const char* a2 = last ? nA : cA + (size_t)(t + 2) * kstep; const char* b2 = last ? nB : cB + (size_t)(t + 2) * kstep;
            const char* a3 = a2 + kstep; const char* b3 = b2 + kstep;
            const bool useN = GATHER && last && has_next;
            if (last) { if (has_next) { PG8_IDX_USE(); } }
            PG8_LDB(B0, 0, 0); PG8_LDB(B1, 0, 1); PG8_SCHED; PG8_LDA(At, 0, 0); PG8_STAGE_A(PG8_SA(1, 1), a1, 1, false);
            PG8_WAIT_V(8); PG8_WAIT_L(0); PG8_BAR; PG8_MMA(0, 0, At, B0); PG8_MMA(0, 1, At, B1); PG8_BAR; PG8_SCHED;
            PG8_LDA(At, 0, 1); PG8_STAGE(PG8_SB(0, 0), b2, voffB); PG8_STAGE(PG8_SB(0, 1), b2 + hstepB, voffB); PG8_STAGE_A(PG8_SA(0, 0), a2, 0, useN);
            PG8_WAIT_V(8); PG8_WAIT_L(0); PG8_BAR; PG8_MMA(1, 0, At, B0); PG8_MMA(1, 1, At, B1); PG8_BAR; PG8_SCHED;
            PG8_LDB(B0, 1, 0); PG8_LDB(B1, 1, 1); PG8_SCHED; PG8_LDA(At, 1, 0); PG8_STAGE_A(PG8_SA(0, 1), a2, 1, useN);
            PG8_WAIT_V(8); PG8_WAIT_L(0); PG8_BAR; PG8_MMA(0, 0, At, B0); PG8_MMA(0, 1, At, B1); PG8_BAR; PG8_SCHED;
            PG8_LDA(At, 1, 1); PG8_STAGE(PG8_SB(1, 0), b3, voffB); PG8_STAGE(PG8_SB(1, 1), b3 + hstepB, voffB); PG8_STAGE_A(PG8_SA(1, 0), a3, 0, useN);
            PG8_WAIT_V(8); PG8_WAIT_L(0); PG8_BAR; PG8_MMA(1, 0, At, B0); PG8_MMA(1, 1, At, B1); PG8_BAR; PG8_SCHED;
        }
        if constexpr (ALIGN_EPI) { if (wr == 0) PG8_BAR; }
        asm volatile("s_nop 15\n\ts_nop 15" ::: "memory");
        E(acc, cur, wr, wc, fr, fq);
        if (!has_next) break;
#pragma unroll
        for (int a = 0; a < 2; ++a)
#pragma unroll
            for (int b = 0; b < 2; ++b)
#pragma unroll
                for (int m = 0; m < 4; ++m)
#pragma unroll
                    for (int n = 0; n < 2; ++n) acc[a][b][m][n] = (f32x4){0.f, 0.f, 0.f, 0.f};
        cur = nxt; cA = nA; cB = nB; ++ui;
        if constexpr (GATHER) {
#pragma unroll
            for (int h_ = 0; h_ < 2; ++h_)
#pragma unroll
                for (int i_ = 0; i_ < 2; ++i_) vC[h_][i_] = vN[h_][i_]; }
        if constexpr (ALIGN_EPI) { if (wr == 1) PG8_BAR; }
    }
    PG8_WAIT_V(0);
    if constexpr (!ALIGN_EPI) { if (wr == 0) PG8_BAR; }
    PG8_BAR;
#undef PG8_IDX_ISSUE
#undef PG8_IDX_USE
#undef PG8_STAGE_A
#undef PG8_SA
#undef PG8_SB
#undef PG8_STAGE
#undef PG8_LDA
#undef PG8_LDB
#undef PG8_MMA
#undef PG8_WAIT_V
#undef PG8_WAIT_L
#undef PG8_BAR
#undef PG8_SCHED
}
}

#define XB_TMO      128
#define XB_XCNT(j)  (256  + 64 * (j))
#define XB_XSUB(j)  (1280 + 64 * (j))
#define XB_XGEN(j)  (2304 + 64 * (j))
#define XB_TOP      3328
#define XB_TOPGEN   3392
#define XCD_BAR_WORDS 3456
#define XB_SPIN_CAP (1u << 18)
__device__ __forceinline__ unsigned xb_ld(unsigned* p)              { return __hip_atomic_load(p, __ATOMIC_RELAXED, __HIP_MEMORY_SCOPE_AGENT); }
__device__ __forceinline__ unsigned xb_add(unsigned* p, unsigned v) { return __hip_atomic_fetch_add(p, v, __ATOMIC_RELAXED, __HIP_MEMORY_SCOPE_AGENT); }
__device__ __forceinline__ unsigned xb_xcc_id() { return (unsigned)__builtin_amdgcn_s_getreg((3 << 11) | 20) & 0xFu; }
#define XB_SPIN(cond, bar) do { unsigned _sp = 0; while (cond) { __builtin_amdgcn_s_sleep(1); \
    if ((++_sp & 255u) == 0u) { if (xb_ld(&(bar)[XB_TMO])) break; if (_sp > XB_SPIN_CAP) { atomicAdd(&(bar)[XB_TMO], 1u); break; } } } } while (0)
struct XcdBarrier { unsigned* bar; unsigned x; volatile LAS unsigned* st; };
__device__ __forceinline__ XcdBarrier xcd_barrier_post(unsigned* bar, volatile LAS unsigned* st) {
    XcdBarrier b; b.bar = bar; b.x = xb_xcc_id(); b.st = st;
    if (threadIdx.x == 0) (void)xb_add(&bar[XB_XCNT(b.x)], 1u);
    return b;
}
__device__ __forceinline__ void xcd_barrier_complete(unsigned* bar, unsigned x, unsigned& nloc, unsigned& nx) {
    const unsigned G = gridDim.x * gridDim.y * gridDim.z;
    unsigned sum, cnt, mine, sp = 0u;
    for (;;) {
        sum = 0u; cnt = 0u; mine = 0u;
#pragma unroll
        for (unsigned j = 0; j < 16; ++j) { const unsigned c = xb_ld(&bar[XB_XCNT(j)]); sum += c; cnt += (c > 0u) ? 1u : 0u; mine = (j == x) ? c : mine; }
        if (sum == G) break;
        __builtin_amdgcn_s_sleep(1);
        if ((++sp & 255u) == 0u) { if (xb_ld(&bar[XB_TMO])) break; if (sp > XB_SPIN_CAP) { atomicAdd(&bar[XB_TMO], 1u); break; } }
    }
    nloc = mine > 0u ? mine : 1u; nx = cnt > 0u ? cnt : 1u;
}
__device__ __forceinline__ void xcd_barrier(const XcdBarrier& b) {
    asm volatile("s_waitcnt vmcnt(0)" ::: "memory");
    __syncthreads();
    if (threadIdx.x == 0) {
        unsigned* bar = b.bar;
        __builtin_amdgcn_s_waitcnt(0);
        unsigned nloc = b.st[0], nx = b.st[1];
        if (nloc == 0u) { xcd_barrier_complete(bar, b.x, nloc, nx); b.st[0] = nloc; b.st[1] = nx; }
        const unsigned old = xb_add(&bar[XB_XSUB(b.x)], 1u);
        const unsigned gen = old / nloc;
        if (old + 1u == (gen + 1u) * nloc) {
            __builtin_amdgcn_fence(__ATOMIC_RELEASE, "agent");
            asm volatile("s_waitcnt vmcnt(0)" ::: "memory");
            const unsigned og = xb_add(&bar[XB_TOP], 1u);
            const unsigned tg = og / nx;
            if (og + 1u == (tg + 1u) * nx) xb_add(&bar[XB_TOPGEN], 1u);
            else XB_SPIN(xb_ld(&bar[XB_TOPGEN]) == tg, bar);
            __builtin_amdgcn_fence(__ATOMIC_ACQUIRE, "agent");
            xb_add(&bar[XB_XGEN(b.x)], 1u);
            asm volatile("s_waitcnt vmcnt(0)" ::: "memory");
        } else {
            XB_SPIN(xb_ld(&bar[XB_XGEN(b.x)]) == gen, bar);
            __builtin_amdgcn_fence(__ATOMIC_ACQUIRE, "agent");
            asm volatile("s_waitcnt vmcnt(0)" ::: "memory");
        }
    }
    __syncthreads();
}

struct Args { const float* in[29]; float* out; unsigned char* ws; int ph_lo, ph_hi; };
enum { I_X = 0, I_C, I_CTX, I_CCTX, I_WMOD, I_BMOD, I_NPREMIX, I_NPOSTMIX, I_NPREFFN, I_NPOSTFFN, I_WIN, I_CONVW, I_CONVB, I_WA, I_BA, I_WX, I_BX, I_LAM,
       I_POOLW, I_POOLS, I_WRNN, I_WPOOL, I_WOUT, I_RW, I_RB, I_W1, I_B1, I_W2, I_B2 };

struct Frame { LAS unsigned char* lds; int tid, lane, wave, G, blk; };

struct TrDesc { const float* src; bf16* dst; int ldw, ldt, k0, n0, kind, p0, p1; };
__device__ __forceinline__ int tr_row(const TrDesc& d, int n) {
    if (d.kind == 0 || d.kind == 3) return d.p0 + n;
    if (d.kind == 1) { const int cg = n >> 6, cc = n & 63, g = d.p1; return (d.p0 * 4 + cg) * 256 + 128 * (g >> 1) + 32 * (cc >> 4) + 16 * (g & 1) + (cc & 15); }
    const int j = n & 1023; return d.p0 * 2048 + (j >> 7) * 256 + (n >> 10) * 128 + (j & 127);
}
__device__ __forceinline__ bool tr_decode(const Args& a, int it, TrDesc& d) {
    constexpr int I0 = 16 * 160, I1 = 16 * 32, I2 = 4 * 32, I3 = 512, I4 = 512, I5 = 512;
    unsigned char* ws = a.ws; int r = it; d.kind = 0; d.p0 = 0; d.p1 = 0;
    if (r < I0) { const int kb = r / 160, nb = r % 160; d.src = a.in[I_WIN]; d.ldw = INC; d.dst = (bf16*)(ws + WS_WIN); d.ldt = 1024; d.k0 = kb * 64; d.n0 = nb * 32; return true; } r -= I0;
    if (r < I1) { const int mat = r >> 5, q = r & 31, kb = q >> 3, nb = q & 7; const int dir = mat >> 3, type = (mat >> 2) & 1, h = mat & 3;
        d.src = (type ? a.in[I_WX] : a.in[I_WA]) + (size_t)(dir * 4 + h) * 65536; d.ldw = 256; d.dst = (bf16*)(ws + WS_WG); d.ldt = 256; d.k0 = kb * 64; d.n0 = nb * 32; d.kind = 1; d.p0 = h; d.p1 = dir * 2 + type; return true; } r -= I1;
    if (r < I2) { const int gq = r >> 5, q = r & 31, kb = q >> 3, nb = q & 7; d.src = a.in[I_POOLW] + (size_t)gq * 65536; d.ldw = 256; d.dst = (bf16*)(ws + WS_WP); d.ldt = 256; d.k0 = kb * 64; d.n0 = nb * 32; d.p0 = gq * 256; return true; } r -= I2;
    if (r < I3) { const int kb = r >> 5, nb = r & 31; d.src = a.in[I_WRNN]; d.ldw = 1024; d.dst = (bf16*)(ws + WS_WPROJ); d.ldt = 1024; d.k0 = kb * 64; d.n0 = nb * 32; return true; } r -= I3;
    if (r < I4) { const int kb = r >> 5, nb = r & 31; d.src = a.in[I_WPOOL]; d.ldw = 1024; d.dst = (bf16*)(ws + WS_WPROJ); d.ldt = 1024; d.k0 = kb * 64; d.n0 = nb * 32; d.p0 = 1024; return true; } r -= I4;
    if (r < I5) { const int kb = r >> 5, nb = r & 31; d.src = a.in[I_WOUT]; d.ldw = 1024; d.dst = (bf16*)(ws + WS_WOUT); d.ldt = 1024; d.k0 = kb * 64; d.n0 = nb * 32; return true; } r -= I5;
    return false;
}
__device__ __forceinline__ void tr_load(const TrDesc& d, f32x4 (&v)[8], int lane) {
    const float* p = d.src + (size_t)(d.k0 + (lane >> 3)) * d.ldw + d.n0 + (lane & 7) * 4;
#pragma unroll
    for (int i = 0; i < 8; ++i) v[i] = __builtin_nontemporal_load((const f32x4*)(p + (size_t)(8 * i) * d.ldw));
}
__device__ __forceinline__ void tr_store(const TrDesc& d, const f32x4 (&v)[8], LAS float* scr, int lane) {
    const int kr = lane >> 3, n4 = (lane & 7) * 4;
#pragma unroll
    for (int i = 0; i < 8; ++i) { LAS float* s = scr + (kr + 8 * i) * 33 + n4; s[0] = v[i].x; s[1] = v[i].y; s[2] = v[i].z; s[3] = v[i].w; }
    LDS_WAIT(); asm volatile("" ::: "memory");
    const int c = lane & 7;
#pragma unroll
    for (int j = 0; j < 4; ++j) { const int n = (lane >> 3) + 8 * j; const LAS float* s = scr + (8 * c) * 33 + n;
        u32x4 o; o.x = cvt_pk_bf16(s[0 * 33], s[1 * 33]); o.y = cvt_pk_bf16(s[2 * 33], s[3 * 33]); o.z = cvt_pk_bf16(s[4 * 33], s[5 * 33]); o.w = cvt_pk_bf16(s[6 * 33], s[7 * 33]);
        *(u32x4*)(d.dst + (size_t)tr_row(d, d.n0 + n) * d.ldt + d.k0 + 8 * c) = o; }
    LDS_WAIT(); asm volatile("" ::: "memory");
}

__device__ __forceinline__ void p0_expert_tiles(const Frame& F, const Args& a) {
    LAS float* scr = (LAS float*)F.lds;
    constexpr int T1 = 32 * 8 * 16, T2 = 32 * 8 * 8, NT = T1 + T2;
    const int r16 = F.tid >> 5, c4 = (F.tid & 31) * 4, tn_ = F.tid >> 2, kq = F.tid & 3;
    f32x4 v[8];
    auto src_of = [&](int t, int& ldw) -> const float* {
        if (t < T1) { const int e = t >> 7, q = t & 127, kb = q >> 4, nb = q & 15; ldw = 2048; return a.in[I_W1] + (size_t)e * 1024 * 2048 + (size_t)(kb * 128) * 2048 + nb * 128; }
        const int u = t - T1, e = u >> 6, q = u & 63, kb = q >> 3, nb = q & 7; ldw = 1024; return a.in[I_W2] + (size_t)e * 1024 * 1024 + (size_t)(kb * 128) * 1024 + nb * 128; };
    auto dst_of = [&](int t) -> unsigned char* {
        if (t < T1) { const int e = t >> 7, q = t & 127, kb = q >> 4, nb = q & 15; return a.ws + WS_W1T + ((size_t)e * 2048 + (nb & 7) * 256 + (nb >> 3) * 128) * 1024 + kb * 128; }
        const int u = t - T1, e = u >> 6, q = u & 63, kb = q >> 3, nb = q & 7; return a.ws + WS_W2T + ((size_t)e * 1024 + nb * 128) * 1024 + kb * 128; };
    unsigned* qhead = (unsigned*)(a.ws + WS_CTL) + CW_TILEQ; LAS int* qslot = (LAS int*)(F.lds + LDS_CNT);
    auto grab = [&]() -> int { if (F.tid == 0) qslot[0] = (int)__hip_atomic_fetch_add(qhead, 1u, __ATOMIC_RELAXED, __HIP_MEMORY_SCOPE_AGENT); __syncthreads(); const int r = qslot[0]; __syncthreads(); return r; };
    int t = grab(), tn = grab();
    if (t < NT) { int ldw; const float* s = src_of(t, ldw) + (size_t)r16 * ldw + c4;
#pragma unroll
        for (int i = 0; i < 8; ++i) v[i] = __builtin_nontemporal_load((const f32x4*)(s + (size_t)(16 * i) * ldw)); }
    while (t < NT) {
        int rq = 0; if (F.tid == 0) rq = (int)__hip_atomic_fetch_add(qhead, 1u, __ATOMIC_RELAXED, __HIP_MEMORY_SCOPE_AGENT);
#pragma unroll
        for (int i = 0; i < 8; ++i) { LAS float* p = scr + (r16 + 16 * i) * 129 + c4; p[0] = v[i].x; p[1] = v[i].y; p[2] = v[i].z; p[3] = v[i].w; }
        __syncthreads();
        if (tn < NT) { int ldw; const float* s = src_of(tn, ldw) + (size_t)r16 * ldw + c4;
#pragma unroll
            for (int i = 0; i < 8; ++i) v[i] = __builtin_nontemporal_load((const f32x4*)(s + (size_t)(16 * i) * ldw)); }
        unsigned o[8]; const LAS float* q = scr + (32 * kq) * 129 + tn_;
#pragma unroll
        for (int w = 0; w < 8; ++w) { int x = __builtin_amdgcn_cvt_pk_fp8_f32(q[(4 * w) * 129] * W8SCALE, q[(4 * w + 1) * 129] * W8SCALE, 0, false);
            x = __builtin_amdgcn_cvt_pk_fp8_f32(q[(4 * w + 2) * 129] * W8SCALE, q[(4 * w + 3) * 129] * W8SCALE, x, true); o[w] = (unsigned)x; }
        unsigned char* d = dst_of(t) + (size_t)tn_ * 1024 + 32 * kq;
        __builtin_nontemporal_store((u32x4){o[0], o[1], o[2], o[3]}, (u32x4*)d); __builtin_nontemporal_store((u32x4){o[4], o[5], o[6], o[7]}, (u32x4*)(d + 16));
        if (F.tid == 0) qslot[0] = rq;
        __syncthreads();
        t = tn; tn = qslot[0];
    }
}

__device__ __forceinline__ void p0_prologue(const Frame& F, const Args& a) {
    unsigned char* ws = a.ws;
    if (F.blk < 96) {
        LAS float* sil = (LAS float*)(F.lds);
        LAS float* red = (LAS float*)(F.lds + 16384);
        for (int i = F.tid; i < 3 * 1024; i += 512) { const int r = i >> 10, k = i & 1023; const float cv = (r < 2) ? a.in[I_C][r * 1024 + k] : a.in[I_CCTX][k]; sil[i] = cv * frcp(1.0f + fexp2(-LOG2E * cv)); }
        __syncthreads();
        const int col = F.blk * 64 + F.lane; const float* wm = a.in[I_WMOD] + col;
        float a0 = 0.f, a1 = 0.f, a2 = 0.f;
        const int kb = F.wave * 128;
#pragma unroll 32
        for (int k = 0; k < 128; ++k) { const float w = __builtin_nontemporal_load(wm + (size_t)(kb + k) * 6144); a0 += sil[kb + k] * w; a1 += sil[1024 + kb + k] * w; a2 += sil[2048 + kb + k] * w; }
        red[(F.wave * 3 + 0) * 64 + F.lane] = a0; red[(F.wave * 3 + 1) * 64 + F.lane] = a1; red[(F.wave * 3 + 2) * 64 + F.lane] = a2;
        __syncthreads();
        if (F.tid < 192) { const int r = F.tid >> 6, l = F.tid & 63; float s = a.in[I_BMOD][F.blk * 64 + l];
#pragma unroll
            for (int w = 0; w < 8; ++w) s += red[(w * 3 + r) * 64 + l];
            ((float*)(ws + WS_MOD))[r * 6144 + F.blk * 64 + l] = s; }
        VM_WAIT();
        __syncthreads();
        if (F.blk < 32 && F.tid == 0) {
            __builtin_amdgcn_fence(__ATOMIC_RELEASE, "agent"); VM_WAIT();
            __hip_atomic_fetch_add((unsigned*)(ws + WS_CTL) + CW_MODFLAG, 1u, __ATOMIC_RELAXED, __HIP_MEMORY_SCOPE_AGENT); }
    }
    const int gtid = F.blk * 512 + F.tid, NGT = F.G * 512;
    for (int i = gtid; i < 2048; i += NGT) { const float lam = a.in[I_LAM][i]; ((float*)(ws + WS_SP2))[i] = 8.0f * LOG2E * log1pf(expf(-lam)); }
    LAS float* scr = (LAS float*)(F.lds + 32768 + F.wave * 8704);
    const int gw = F.blk * 8 + F.wave, NGW = F.G * 8;
    constexpr int NITEMS = 16 * 160 + 16 * 32 + 4 * 32 + 512 * 3;
    {
        TrDesc d0, d1, e0, e1; f32x4 v0[8], v1[8], w0[8], w1[8];
        int it = gw; bool h0 = tr_decode(a, it, d0), h1 = tr_decode(a, it + NGW, d1);
        if (h0) tr_load(d0, v0, F.lane); if (h1) tr_load(d1, v1, F.lane);
        while (h0) {
            const int itn = it + 2 * NGW; const bool g0 = tr_decode(a, itn, e0), g1 = tr_decode(a, itn + NGW, e1);
            if (g0) tr_load(e0, w0, F.lane); if (g1) tr_load(e1, w1, F.lane);
            tr_store(d0, v0, scr, F.lane); if (h1) tr_store(d1, v1, scr, F.lane);
            if (!g0) break;
            const int itm = itn + 2 * NGW; h0 = tr_decode(a, itm, d0); h1 = tr_decode(a, itm + NGW, d1);
            if (h0) tr_load(d0, v0, F.lane); if (h1) tr_load(d1, v1, F.lane);
            tr_store(e0, w0, scr, F.lane); if (g1) tr_store(e1, w1, scr, F.lane);
            it = itm;
        }
    }
    __syncthreads();
    p0_expert_tiles(F, a);
}

__device__ __forceinline__ void p1_prenorm(const Frame& F, const Args& a) {
    const float* mod = (const float*)(a.ws + WS_MOD); bf16* U = (bf16*)(a.ws + WS_U);
    if (F.tid == 0) {
        unsigned* flag = (unsigned*)(a.ws + WS_CTL) + CW_MODFLAG; unsigned sp = 0;
        while (__hip_atomic_load(flag, __ATOMIC_RELAXED, __HIP_MEMORY_SCOPE_AGENT) < 32u) { __builtin_amdgcn_s_sleep(4); if (++sp > (1u << 22)) break; }
        __builtin_amdgcn_fence(__ATOMIC_ACQUIRE, "agent"); VM_WAIT(); }
    __syncthreads();
    const int gw = F.blk * 8 + F.wave, NGW = F.G * 8;
    f32x4 Av[4], Bv[4], v[4], vn[4]; int curset = -1;
    if (gw < MT) { const float* src = gw < ML ? a.in[I_X] + (size_t)gw * D : a.in[I_CTX] + (size_t)(gw - ML) * D;
#pragma unroll
        for (int j = 0; j < 4; ++j) v[j] = __builtin_nontemporal_load((const f32x4*)(src + 4 * F.lane + 256 * j)); }
    for (int r = gw; r < MT; r += NGW) {
        const int rn = r + NGW;
        if (rn < MT) { const float* src = rn < ML ? a.in[I_X] + (size_t)rn * D : a.in[I_CTX] + (size_t)(rn - ML) * D;
#pragma unroll
            for (int j = 0; j < 4; ++j) vn[j] = __builtin_nontemporal_load((const f32x4*)(src + 4 * F.lane + 256 * j)); }
        const int set = r < SEQ ? 0 : (r < ML ? 1 : 2);
        if (set != curset) { curset = set;
#pragma unroll
            for (int j = 0; j < 4; ++j) { const int k = 4 * F.lane + 256 * j; const f32x4 gn = *(const f32x4*)(a.in[I_NPREMIX] + k), sc = *(const f32x4*)(mod + set * 6144 + 1024 + k); Av[j] = gn * (sc + 1.0f); Bv[j] = *(const f32x4*)(mod + set * 6144 + k); } }
        float ss = 0.f;
#pragma unroll
        for (int j = 0; j < 4; ++j) ss += (v[j].x * v[j].x + v[j].y * v[j].y) + (v[j].z * v[j].z + v[j].w * v[j].w);
        const float rs = __builtin_amdgcn_rsqf(wave_sum(ss) * (1.0f / D) + EPS);
#pragma unroll
        for (int j = 0; j < 4; ++j) { const f32x4 o = v[j] * rs * Av[j] + Bv[j]; u32x2 w; w.x = cvt_pk_bf16(o.x, o.y); w.y = cvt_pk_bf16(o.z, o.w); *(u32x2*)(U + (size_t)r * D + 4 * F.lane + 256 * j) = w; }
#pragma unroll
        for (int j = 0; j < 4; ++j) v[j] = vn[j];
    }
}

__device__ __forceinline__ void p3_conv_pool(const Frame& F, const Args& a) {
    const bf16* PROJ = (const bf16*)(a.ws + WS_PROJ); bf16* XC = (bf16*)(a.ws + WS_XC); bf16* DP = (bf16*)(a.ws + WS_DP);
    const int gtid = F.blk * 512 + F.tid, NGT = F.G * 512;
    for (int it = gtid; it < MT * 128; it += NGT) {
        const int r = it >> 7, c0 = (it & 127) * 8;
        int sb, t, len; if (r < ML) { sb = r & ~(SEQ - 1); t = r & (SEQ - 1); len = SEQ; } else { const int rr = r - ML; sb = ML + (rr & ~(CTXL - 1)); t = rr & (CTXL - 1); len = CTXL; }
        u32x4 cx[4]; float cm[4];
#pragma unroll
        for (int j = 0; j < 4; ++j) { const int tt = t - 2 + j; const bool ok = tt >= 0 && tt < len; cm[j] = ok ? 1.0f : 0.0f; cx[j] = *(const u32x4*)(PROJ + (size_t)(sb + (ok ? tt : t)) * INC + c0); }
        const bool lat = r < ML; const int rl = lat ? r : 0;
        const int pos = rl & 63, rb = rl - pos, h = 1 << (c0 >> 8); const int lo = pos - h < 0 ? 0 : pos - h, hi = pos + h > 64 ? 64 : pos + h;
        u32x4 px[16]; float pm[16];
        if (lat) {
#pragma unroll
            for (int q = 0; q < 16; ++q) { const int p = lo + q; const bool ok = p < hi; pm[q] = ok ? 1.0f : 0.0f; px[q] = *(const u32x4*)(PROJ + (size_t)(rb + (ok ? p : pos)) * INC + 2048 + c0); } }
        float acc[8];
        { const f32x4 b0 = *(const f32x4*)(a.in[I_CONVB] + c0), b1 = *(const f32x4*)(a.in[I_CONVB] + c0 + 4); acc[0] = b0.x; acc[1] = b0.y; acc[2] = b0.z; acc[3] = b0.w; acc[4] = b1.x; acc[5] = b1.y; acc[6] = b1.z; acc[7] = b1.w; }
#pragma unroll
        for (int j = 0; j < 4; ++j) { const u32x4 xv = cx[j]; const f32x4 w0 = *(const f32x4*)(a.in[I_CONVW] + j * 1024 + c0) * cm[j], w1 = *(const f32x4*)(a.in[I_CONVW] + j * 1024 + c0 + 4) * cm[j];
            acc[0] += w0.x * blo(xv.x); acc[1] += w0.y * bhi(xv.x); acc[2] += w0.z * blo(xv.y); acc[3] += w0.w * bhi(xv.y); acc[4] += w1.x * blo(xv.z); acc[5] += w1.y * bhi(xv.z); acc[6] += w1.z * blo(xv.w); acc[7] += w1.w * bhi(xv.w); }
        { u32x4 o; o.x = cvt_pk_bf16(acc[0], acc[1]); o.y = cvt_pk_bf16(acc[2], acc[3]); o.z = cvt_pk_bf16(acc[4], acc[5]); o.w = cvt_pk_bf16(acc[6], acc[7]); *(u32x4*)(XC + (size_t)r * D + c0) = o; }
        if (lat) {
            float s[8];
#pragma unroll
            for (int i = 0; i < 8; ++i) s[i] = 0.f;
#pragma unroll
            for (int q = 0; q < 16; ++q) { const u32x4 xv = px[q]; const float m = pm[q];
                s[0] += m * blo(xv.x); s[1] += m * bhi(xv.x); s[2] += m * blo(xv.y); s[3] += m * bhi(xv.y); s[4] += m * blo(xv.z); s[5] += m * bhi(xv.z); s[6] += m * blo(xv.w); s[7] += m * bhi(xv.w); }
            const float inv = 1.0f / (float)(hi - lo); const u32x4 xs = *(const u32x4*)(PROJ + (size_t)r * INC + 2048 + c0);
            u32x4 o; o.x = cvt_pk_bf16(s[0] * inv - blo(xs.x), s[1] * inv - bhi(xs.x)); o.y = cvt_pk_bf16(s[2] * inv - blo(xs.y), s[3] * inv - bhi(xs.y));
            o.z = cvt_pk_bf16(s[4] * inv - blo(xs.z), s[5] * inv - bhi(xs.z)); o.w = cvt_pk_bf16(s[6] * inv - blo(xs.w), s[7] * inv - bhi(xs.w));
            *(u32x4*)(DP + (size_t)r * D + c0) = o;
        }
    }
}

__device__ __forceinline__ void p6_carry(const Frame& F, const Args& a) {
    const float* AGG = (const float*)(a.ws + WS_AGG); float* CARRY = (float*)(a.ws + WS_CARRY);
    if (F.wave != 0) return;
    for (int w = F.blk; w < 256; w += F.G) {
        const int chain = w * 16 + (F.lane >> 2), seg = F.lane & 3, ch = chain & 1023, dir = (chain >> 10) & 1, b = chain >> 11;
        float A[33], E[33];
#pragma unroll
        for (int u = 0; u < 33; ++u) { const int k = 33 * seg + u; const int s = k < 4 ? NSUB_L + b * 4 + (dir ? 3 - k : k) : b * 128 + (dir ? 127 - (k - 4) : (k - 4));
            A[u] = AGG[((size_t)(s * 2 + dir) * 2) * D + ch]; E[u] = AGG[((size_t)(s * 2 + dir) * 2 + 1) * D + ch]; }
        float As = 0.f, hs = 0.f;
#pragma unroll
        for (int u = 0; u < 33; ++u) { As += A[u]; hs = fexp2(A[u]) * hs + E[u]; }
        float hin = 0.f;
#pragma unroll
        for (int j = 0; j < 3; ++j) { const float Aj = __shfl(As, (F.lane & ~3) + j), hj = __shfl(hs, (F.lane & ~3) + j); if (j < seg) hin = fexp2(Aj) * hin + hj; }
        float h = hin;
#pragma unroll
        for (int u = 0; u < 33; ++u) { const int k = 33 * seg + u;
            if (k >= 4) { const int s = b * 128 + (dir ? 127 - (k - 4) : (k - 4)); CARRY[(size_t)(s * 2 + dir) * D + ch] = h; }
            h = fexp2(A[u]) * h + E[u]; }
    }
}

__device__ __forceinline__ void p7_scan_out(const Frame& F, const Args& a) {
    const float* CARRY = (const float*)(a.ws + WS_CARRY);
    const int gw = F.blk * 8 + F.wave, NGW = F.G * 8;
    for (int it = gw; it < NSUB_L * 8; it += NGW) {
        const int sub = it >> 3, c0 = (it & 7) * 128 + F.lane * 2, r0 = sub * 64;
        unsigned hf[64];
        { const unsigned* la = (const unsigned*)((const bf16*)(a.ws + WS_LAF) + (size_t)r0 * D + c0); const unsigned* bb = (const unsigned*)((const bf16*)(a.ws + WS_BF) + (size_t)r0 * D + c0);
          const f32x2 cf = *(const f32x2*)(CARRY + (size_t)(sub * 2 + 0) * D + c0); float h0 = cf.x, h1 = cf.y;
          unsigned lv[16], bv[16], ln[16], bn[16];
#pragma unroll
          for (int u = 0; u < 16; ++u) { lv[u] = la[(size_t)u * (D / 2)]; bv[u] = bb[(size_t)u * (D / 2)]; }
#pragma unroll
          for (int tb = 0; tb < 4; ++tb) { const int t0 = tb * 16;
              if (tb < 3) {
#pragma unroll
                  for (int u = 0; u < 16; ++u) { ln[u] = la[(size_t)(t0 + 16 + u) * (D / 2)]; bn[u] = bb[(size_t)(t0 + 16 + u) * (D / 2)]; } }
#pragma unroll
              for (int u = 0; u < 16; ++u) { h0 = fexp2(blo(lv[u])) * h0 + blo(bv[u]); h1 = fexp2(bhi(lv[u])) * h1 + bhi(bv[u]); hf[t0 + u] = cvt_pk_bf16(h0, h1); }
#pragma unroll
              for (int u = 0; u < 16; ++u) { lv[u] = ln[u]; bv[u] = bn[u]; } } }
        { const unsigned* la = (const unsigned*)((const bf16*)(a.ws + WS_LAB) + (size_t)r0 * D + c0); const unsigned* bb = (const unsigned*)((const bf16*)(a.ws + WS_BB) + (size_t)r0 * D + c0);
          const unsigned* gp = (const unsigned*)((const bf16*)(a.ws + WS_PROJ) + (size_t)r0 * INC + 1024 + c0);
          unsigned* y = (unsigned*)((bf16*)(a.ws + WS_YY) + (size_t)r0 * D + c0);
          const f32x2 cb = *(const f32x2*)(CARRY + (size_t)(sub * 2 + 1) * D + c0); float h0 = cb.x, h1 = cb.y;
          unsigned lv[16], bv[16], gv[16], ln[16], bn[16], gn[16];
#pragma unroll
          for (int u = 0; u < 16; ++u) { const int t = 63 - u; lv[u] = la[(size_t)t * (D / 2)]; bv[u] = bb[(size_t)t * (D / 2)]; gv[u] = gp[(size_t)t * (INC / 2)]; }
#pragma unroll
          for (int sb = 0; sb < 4; ++sb) { const int s0 = sb * 16;
              if (sb < 3) {
#pragma unroll
                  for (int u = 0; u < 16; ++u) { const int t = 63 - (s0 + 16 + u); ln[u] = la[(size_t)t * (D / 2)]; bn[u] = bb[(size_t)t * (D / 2)]; gn[u] = gp[(size_t)t * (INC / 2)]; } }
#pragma unroll
              for (int u = 0; u < 16; ++u) { const int t = 63 - (s0 + u); h0 = fexp2(blo(lv[u])) * h0 + blo(bv[u]); h1 = fexp2(bhi(lv[u])) * h1 + bhi(bv[u]);
                  y[(size_t)t * (D / 2)] = cvt_pk_bf16((blo(hf[t]) + h0) * blo(gv[u]), (bhi(hf[t]) + h1) * bhi(gv[u])); }
#pragma unroll
              for (int u = 0; u < 16; ++u) { lv[u] = ln[u]; bv[u] = bn[u]; gv[u] = gn[u]; } } }
    }
}

__device__ __forceinline__ void p10_post_mix_route(const Frame& F, const Args& a, int bank = 0) {
    const float* mod = (const float*)(a.ws + WS_MOD); const bf16* MLAT = (const bf16*)(a.ws + WS_MLAT); unsigned char* VB = (unsigned char*)(a.ws + WS_VB); bf16* X1 = (bf16*)(a.ws + WS_X1);
    int* pair_e = (int*)(a.ws + WS_PAIR_E); float* pair_w = (float*)(a.ws + WS_PAIR_W); int* pair_pos = (int*)(a.ws + WS_PAIR_POS);
    unsigned* gcnt = (unsigned*)(a.ws + WS_CTL) + CW_GCNT + bank * 2048;
    LAS float* vt = (LAS float*)F.lds;
    LAS float* red = (LAS float*)F.lds;
    LAS float* lgt = (LAS float*)(F.lds + LDS_LGT);
    LAS int* lcnt = (LAS int*)(F.lds + LDS_CNT); LAS int* lbase = lcnt + 32; LAS int* rec_e = lcnt + 64; LAS int* rec_lp = lcnt + 64 + 256;
    float wreg[64];
#pragma unroll
    for (int s = 0; s < 64; ++s) wreg[s] = a.in[I_RW][(size_t)(128 * F.wave + 2 * s + (F.lane >> 5)) * 32 + (F.lane & 31)];
    if (F.tid < 32) lcnt[F.tid] = 0;
    __syncthreads();
    for (int r0 = F.blk * 64; r0 < ML; r0 += F.G * 64) {
        const int b = r0 >> 13; const float* mb = mod + b * 6144;
        f32x4 Gm[4], Av[4], Bv[4];
        { f32x4 t0[4], t1[4], t2[4], t3[4];
#pragma unroll
          for (int j = 0; j < 4; ++j) { const int k = 4 * F.lane + 256 * j; t0[j] = *(const f32x4*)(mb + 2048 + k); t1[j] = *(const f32x4*)(a.in[I_NPOSTMIX] + k); t2[j] = *(const f32x4*)(a.in[I_NPREFFN] + k); t3[j] = *(const f32x4*)(mb + 4096 + k); Bv[j] = *(const f32x4*)(mb + 3072 + k); }
#pragma unroll
          for (int j = 0; j < 4; ++j) { Gm[j] = t0[j] * t1[j]; Av[j] = t2[j] * (t3[j] + 1.0f); } }
        for (int pass = 0; pass < 2; ++pass) {
            const int rw0 = r0 + pass * 32 + F.wave * 4;
            u32x2 mln[4]; f32x4 xn[4];
#pragma unroll
            for (int j = 0; j < 4; ++j) { const size_t o = (size_t)rw0 * D + 4 * F.lane + 256 * j; mln[j] = *(const u32x2*)(MLAT + o); xn[j] = *(const f32x4*)(a.in[I_X] + o); }
            for (int i = 0; i < 4; ++i) {
                const int r = rw0 + i, t = F.wave * 4 + i;
                f32x4 v[4], x1[4]; float ss = 0.f;
#pragma unroll
                for (int j = 0; j < 4; ++j) { v[j] = (f32x4){blo(mln[j].x), bhi(mln[j].x), blo(mln[j].y), bhi(mln[j].y)}; x1[j] = xn[j]; ss += (v[j].x * v[j].x + v[j].y * v[j].y) + (v[j].z * v[j].z + v[j].w * v[j].w); }
                if (i < 3) {
#pragma unroll
                    for (int j = 0; j < 4; ++j) { const size_t o = (size_t)(r + 1) * D + 4 * F.lane + 256 * j; mln[j] = *(const u32x2*)(MLAT + o); xn[j] = *(const f32x4*)(a.in[I_X] + o); } }
                const float rs1 = __builtin_amdgcn_rsqf(wave_sum(ss) * (1.0f / D) + EPS);
                float ss2 = 0.f;
#pragma unroll
                for (int j = 0; j < 4; ++j) { x1[j] = x1[j] + Gm[j] * (v[j] * rs1); ss2 += (x1[j].x * x1[j].x + x1[j].y * x1[j].y) + (x1[j].z * x1[j].z + x1[j].w * x1[j].w); }
                const float rs2 = __builtin_amdgcn_rsqf(wave_sum(ss2) * (1.0f / D) + EPS);
#pragma unroll
                for (int j = 0; j < 4; ++j) { const int k = 4 * F.lane + 256 * j; v[j] = x1[j] * rs2 * Av[j] + Bv[j];
                    LAS float* vp = vt + t * 1025 + k; vp[0] = v[j].x; vp[1] = v[j].y; vp[2] = v[j].z; vp[3] = v[j].w; }
#pragma unroll
                for (int j = 0; j < 4; ++j) { const int k = 4 * F.lane + 256 * j; { u32x2 xw; xw.x = cvt_pk_bf16(x1[j].x, x1[j].y); xw.y = cvt_pk_bf16(x1[j].z, x1[j].w); *(u32x2*)(X1 + (size_t)r * D + k) = xw; }
                    int w = __builtin_amdgcn_cvt_pk_fp8_f32(v[j].x, v[j].y, 0, false); w = __builtin_amdgcn_cvt_pk_fp8_f32(v[j].z, v[j].w, w, true); *(int*)(VB + (size_t)r * D + k) = w; }
            }
            __syncthreads();
            f32x16 acc;
#pragma unroll
            for (int q = 0; q < 16; ++q) acc[q] = 0.f;
            { const LAS float* ap = vt + (F.lane & 31) * 1025 + 128 * F.wave + (F.lane >> 5);
#pragma unroll
              for (int s = 0; s < 64; ++s) acc = __builtin_amdgcn_mfma_f32_32x32x2f32(ap[2 * s], wreg[s], acc, 0, 0, 0); }
            __syncthreads();
#pragma unroll
            for (int q = 0; q < 16; ++q) { const int tok = (q & 3) + 8 * (q >> 2) + 4 * (F.lane >> 5); red[(F.wave * 32 + tok) * 32 + (F.lane & 31)] = acc[q]; }
            __syncthreads();
#pragma unroll
            for (int q = 0; q < 2; ++q) { const int idx = F.tid + 512 * q, t = idx >> 5, e = idx & 31; float s = a.in[I_RB][e];
#pragma unroll
                for (int w = 0; w < 8; ++w) s += red[(w * 32 + t) * 32 + e];
                lgt[t * 33 + e] = s; }
            __syncthreads();
            if (F.tid < 32) {
                const int t = F.tid, ts = pass * 32 + t, r = r0 + ts;
                float lg[32];
#pragma unroll
                for (int e = 0; e < 32; ++e) lg[e] = lgt[t * 33 + e];
                float tv[4]; int ti[4];
#pragma unroll
                for (int k = 0; k < 4; ++k) { float best = -3.0e38f; int bi = 0;
#pragma unroll
                    for (int e = 0; e < 32; ++e) { if (lg[e] > best) { best = lg[e]; bi = e; } }
                    tv[k] = best; ti[k] = bi;
#pragma unroll
                    for (int e = 0; e < 32; ++e) lg[e] = (e == bi) ? -3.0e38f : lg[e]; }
                const float e1 = fexp2((tv[1] - tv[0]) * LOG2E), e2 = fexp2((tv[2] - tv[0]) * LOG2E), e3 = fexp2((tv[3] - tv[0]) * LOG2E), inv = 1.0f / (1.0f + e1 + e2 + e3);
                const float wk[4] = {inv, e1 * inv, e2 * inv, e3 * inv};
#pragma unroll
                for (int k = 0; k < 4; ++k) { const int e = ti[k]; const int lp = __hip_atomic_fetch_add(lcnt + e, 1, __ATOMIC_RELAXED, __HIP_MEMORY_SCOPE_WORKGROUP);
                    rec_e[ts * 4 + k] = e; rec_lp[ts * 4 + k] = lp; }
                *(int4*)(pair_e + r * 4) = make_int4(ti[0], ti[1], ti[2], ti[3]); *(f32x4*)(pair_w + r * 4) = (f32x4){wk[0], wk[1], wk[2], wk[3]};
            }
        }
        __syncthreads();
        if (F.tid < 32) { const int n = lcnt[F.tid]; lbase[F.tid] = (int)__hip_atomic_fetch_add(gcnt + 64 * F.tid, (unsigned)n, __ATOMIC_RELAXED, __HIP_MEMORY_SCOPE_AGENT); lcnt[F.tid] = 0; }
        __syncthreads();
        if (F.tid < 256) { const int e = rec_e[F.tid], pos = lbase[e] + rec_lp[F.tid]; pair_pos[r0 * 4 + F.tid] = pos; ((int*)(a.ws + WS_TOKL))[e * ML + pos] = r0 + (F.tid >> 2); }
        __syncthreads();
    }
}

__device__ __forceinline__ void build_tile_table(const Frame& F, const Args& a) {
    LAS int* tab = (LAS int*)(F.lds + LDS_TAB); LAS int* off = (LAS int*)(F.lds + LDS_CNT) + 640;
    const unsigned* gcnt = (const unsigned*)(a.ws + WS_CTL) + CW_GCNT;
    __syncthreads();
    if (F.tid < 64) {
        const int e = F.lane & 31; const int c = (int)__hip_atomic_load(gcnt + 64 * e, __ATOMIC_RELAXED, __HIP_MEMORY_SCOPE_AGENT); const int n = (c + 255) >> 8;
        int incl = n;
#pragma unroll
        for (int d = 1; d < 32; d <<= 1) { const int t = __shfl_up(incl, d, 32); if (e >= d) incl += t; }
        const int base = incl - n;
        if (F.lane < 32) { off[e] = base * 256; tab[340 + e] = c; for (int i = 0; i < n && base + i < MAXTILES; ++i) tab[base + i] = e | (i << 8);
            if (e == 31) { off[32] = incl * 256; tab[300] = incl < MAXTILES ? incl : MAXTILES; } }
    }
    __syncthreads();
}

__device__ __forceinline__ void p14_final(const Frame& F, const Args& a) {
    const float* mod = (const float*)(a.ws + WS_MOD); const unsigned char* OE = (const unsigned char*)(a.ws + WS_APERM); const bf16* X1 = (const bf16*)(a.ws + WS_X1);
    const int* pair_e = (const int*)(a.ws + WS_PAIR_E); const int* pair_pos = (const int*)(a.ws + WS_PAIR_POS); const float* pair_w = (const float*)(a.ws + WS_PAIR_W);
    const LAS int* off = (const LAS int*)(F.lds + LDS_CNT) + 640;
    const int gw = F.blk * 8 + F.wave, NGW = F.G * 8;
    const int nmine = (ML - gw + NGW - 1) / NGW;
    f32x4 Gm[4]; int curb = -1;
    for (int ib = 0; ib < nmine; ib += 8) {
        int myslot = 0; float myw = 0.f;
        if (F.lane < 32 && ib + (F.lane >> 2) < nmine) { const int r = gw + NGW * (ib + (F.lane >> 2)); myslot = off[pair_e[r * 4 + (F.lane & 3)]] + pair_pos[r * 4 + (F.lane & 3)]; myw = pair_w[r * 4 + (F.lane & 3)] * O8INV; }
        u32x4 ov[4], on[4]; u32x4 x1[2], xn[2];
        { const int r = gw + NGW * ib;
#pragma unroll
          for (int k = 0; k < 4; ++k) { const int slot = __builtin_amdgcn_readlane(myslot, k); ov[k] = *(const u32x4*)(OE + (size_t)slot * D + F.lane * 16); }
#pragma unroll
          for (int j = 0; j < 2; ++j) x1[j] = *(const u32x4*)(X1 + (size_t)r * D + F.lane * 16 + j * 8); }
        for (int i = 0; i < 8 && ib + i < nmine; ++i) {
            const int r = gw + NGW * (ib + i), b = r >> 13;
            if (i + 1 < 8 && ib + i + 1 < nmine) { const int rn = r + NGW;
#pragma unroll
                for (int k = 0; k < 4; ++k) { const int slot = __builtin_amdgcn_readlane(myslot, (i + 1) * 4 + k); on[k] = *(const u32x4*)(OE + (size_t)slot * D + F.lane * 16); }
#pragma unroll
                for (int j = 0; j < 2; ++j) xn[j] = *(const u32x4*)(X1 + (size_t)rn * D + F.lane * 16 + j * 8); }
            if (b != curb) { curb = b;
#pragma unroll
                for (int j = 0; j < 4; ++j) { const int k = F.lane * 16 + j * 4; Gm[j] = *(const f32x4*)(mod + b * 6144 + 5120 + k) * *(const f32x4*)(a.in[I_NPOSTFFN] + k); } }
            float f[16];
#pragma unroll
            for (int q = 0; q < 16; ++q) f[q] = 0.f;
#pragma unroll
            for (int k = 0; k < 4; ++k) { const float w = __builtin_bit_cast(float, __builtin_amdgcn_readlane(__builtin_bit_cast(int, myw), i * 4 + k)); const u32x4 v = ov[k];
                const unsigned vw[4] = {v.x, v.y, v.z, v.w};
#pragma unroll
                for (int q = 0; q < 4; ++q) { const f32x2 lo = __builtin_amdgcn_cvt_pk_f32_fp8((int)vw[q], false), hi = __builtin_amdgcn_cvt_pk_f32_fp8((int)vw[q], true);
                    f[q * 4 + 0] += w * lo.x; f[q * 4 + 1] += w * lo.y; f[q * 4 + 2] += w * hi.x; f[q * 4 + 3] += w * hi.y; } }
            float ss = 0.f;
#pragma unroll
            for (int q = 0; q < 16; ++q) ss += f[q] * f[q];
            const float rs = __builtin_amdgcn_rsqf(wave_sum(ss) * (1.0f / D) + EPS);
#pragma unroll
            for (int j = 0; j < 4; ++j) { const int k = F.lane * 16 + j * 4; const u32x4 xw = x1[j >> 1];
                const f32x4 fv = (f32x4){f[j * 4 + 0], f[j * 4 + 1], f[j * 4 + 2], f[j * 4 + 3]};
                const f32x4 xv = (j & 1) ? (f32x4){blo(xw.z), bhi(xw.z), blo(xw.w), bhi(xw.w)} : (f32x4){blo(xw.x), bhi(xw.x), blo(xw.y), bhi(xw.y)};
                *(f32x4*)(a.out + (size_t)r * D + k) = xv + Gm[j] * (fv * rs); }
#pragma unroll
            for (int k = 0; k < 4; ++k) ov[k] = on[k];
#pragma unroll
            for (int j = 0; j < 2; ++j) x1[j] = xn[j];
        }
    }
}

using pg8::Unit;
struct OrdProj {
    int G, c;
    __device__ __forceinline__ bool next(int i, Unit& u) const { const int L = i * G + c; if (L >= 1288) return false;
        int pm, pn; if (L < 1280) pg8::tile_order(L, 64, 20, pm, pn); else { const int j = L - 1280; pm = 64 + (j & 1); pn = j >> 1; }
        u.pm = pm; u.pn = pn; u.aux = 0; u.aoff = (size_t)pm * 256 * D * 2; u.boff = (size_t)pn * 256 * D * 2; return true; }
};
struct OrdGates {
    int G, c;
    __device__ __forceinline__ bool next(int i, Unit& u) const { const int L = i * G + c; if (L >= 66 * 16) return false;
        int pm, pn; pg8::tile_order(L, 66, 16, pm, pn);
        u.pm = pm; u.pn = pn; u.aux = 0; u.aoff = ((size_t)pm * 256 * D + (pn >> 2) * 256) * 2; u.boff = (size_t)pn * 256 * 256 * 2; return true; }
};
struct OrdPool {
    int G, c;
    __device__ __forceinline__ bool next(int i, Unit& u) const { const int L = i * G + c; if (L >= 256) return false;
        int pm, pn; pg8::tile_order(L, 64, 4, pm, pn);
        u.pm = pm; u.pn = pn; u.aux = 0; u.aoff = ((size_t)pm * 256 * D + pn * 256) * 2; u.boff = (size_t)pn * 256 * 256 * 2; return true; }
};
struct OrdBranch {
    int G, c;
    __device__ __forceinline__ bool next(int i, Unit& u) const { const int L = (i >> 1) * G + c, which = i & 1; if (L >= 256) return false;
        int pm, pn; pg8::tile_order(L, 64, 4, pm, pn);
        u.pm = pm; u.pn = pn; u.aux = which; u.aoff = ((size_t)which * ML + (size_t)pm * 256) * D * 2; u.boff = ((size_t)which * 1024 + (size_t)pn * 256) * D * 2; return true; }
};
struct OrdOut {
    int G, c;
    __device__ __forceinline__ bool next(int i, Unit& u) const { const int L = i * G + c; if (L >= 256) return false;
        int pm, pn; pg8::tile_order(L, 64, 4, pm, pn);
        u.pm = pm; u.pn = pn; u.aux = 0; u.aoff = (size_t)pm * 256 * D * 2; u.boff = (size_t)pn * 256 * D * 2; return true; }
};
template <int NT, bool GATHER> struct OrdMoe {
    int G, c; const LAS int* tab; int ntm;
    __device__ __forceinline__ bool next(int i, Unit& u) const {
        const int cv = (G % 8 == 0) ? (c & 7) * (G >> 3) + (c >> 3) : c; const int L = i * G + cv; if (L >= ntm * NT) return false;
        const int mt = L / NT, nt = L % NT; const int te = __builtin_amdgcn_readfirstlane(tab[mt]); const int e = te & 255, j = te >> 8;
        u.pm = mt; u.pn = nt; u.aux = e; u.boff = ((size_t)e * NT + nt) * 256 * D;
        if (GATHER) { const int cnt = __builtin_amdgcn_readfirstlane(tab[340 + e]); int nv = cnt - j * 256; nv = nv > 256 ? 256 : nv; u.aoff = ((size_t)(unsigned)nv << 32) | (unsigned)(e * ML + j * 256); }
        else u.aoff = (size_t)mt * 256 * D;
        return true; }
};

using pg8::HALF;
struct EpiProj {
    static constexpr bool PERM = true; bf16* O;
    __device__ __forceinline__ void operator()(const f32x4 (&acc)[2][2][4][2], const Unit& u, int wr, int wc, int fr, int fq) const {
        const int row0 = u.pm * 256 + wr * 64 + fr, col0 = u.pn * 256 + wc * 32 + 8 * fq; const int act = (u.pn >= 4 && u.pn < 8) ? 1 : (u.pn >= 12 ? 2 : 0);
#pragma unroll
        for (int ai = 0; ai < 2; ++ai)
#pragma unroll
            for (int m = 0; m < 4; ++m) { bf16* rowp = O + (size_t)(row0 + ai * HALF + m * 16) * INC + col0;
#pragma unroll
                for (int bj = 0; bj < 2; ++bj) { f32x4 v0 = acc[ai][bj][m][0], v1 = acc[ai][bj][m][1];
                    if (act == 1) {
#pragma unroll
                        for (int j = 0; j < 4; ++j) { v0[j] = gelu_tanh_(v0[j]); v1[j] = gelu_tanh_(v1[j]); } }
                    else if (act == 2) {
#pragma unroll
                        for (int j = 0; j < 4; ++j) { v0[j] = sigmoidf_(v0[j]); v1[j] = sigmoidf_(v1[j]); } }
                    u32x4 w; w.x = cvt_pk_bf16(v0[0], v0[1]); w.y = cvt_pk_bf16(v0[2], v0[3]); w.z = cvt_pk_bf16(v1[0], v1[1]); w.w = cvt_pk_bf16(v1[2], v1[3]);
                    *(u32x4*)(rowp + bj * HALF) = w; } }
    }
};
template <int CTRL> __device__ __forceinline__ float dppz(float v) { return __builtin_bit_cast(float, __builtin_amdgcn_update_dpp(0, __builtin_bit_cast(int, v), CTRL, 0xF, 0xF, true)); }
__device__ __forceinline__ float row_prefix(float v) { v += dppz<0x111>(v); v += dppz<0x112>(v); v += dppz<0x114>(v); v += dppz<0x118>(v); return v; }
__device__ __forceinline__ float row_total(float v) { v += dppz<0xB1>(v); v += dppz<0x4E>(v); v += dppz<0x141>(v); v += dppz<0x140>(v); return v; }
struct EpiGates {
    static constexpr bool PERM = false;
    const bf16* XC; bf16 *LAF, *BF, *LAB, *BB; const float *ba, *bx, *sp2; float* AGG;
    __device__ __forceinline__ void one_dir(const f32x4& ar, const f32x4& ag, const float* bap, const float* bxp, const float* spp, const u32x2 xw, bf16* LA, bf16* BO, float (&l)[4], float (&b)[4]) const {
        const f32x4 bav = *(const f32x4*)bap, bxv = *(const f32x4*)bxp, spv = *(const f32x4*)spp; const float xc[4] = {blo(xw.x), bhi(xw.x), blo(xw.y), bhi(xw.y)};
#pragma unroll
        for (int j = 0; j < 4; ++j) { const float r = sigmoidf_(ar[j] + bav[j]), ig = sigmoidf_(ag[j] + bxv[j]); const float l2 = -r * spv[j], av = fexp2(l2); l[j] = l2; b[j] = __builtin_amdgcn_sqrtf(fmaxf(1.0f - av * av, 0.f)) * ig * xc[j]; }
        u32x2 w; w.x = cvt_pk_bf16(l[0], l[1]); w.y = cvt_pk_bf16(l[2], l[3]); *(u32x2*)LA = w;
        w.x = cvt_pk_bf16(b[0], b[1]); w.y = cvt_pk_bf16(b[2], b[3]); *(u32x2*)BO = w;
        asm volatile("" ::: "memory");
    }
    template <bool FWD> __device__ __forceinline__ void agg_dir(const float (&la)[4][4], const float (&bb)[4][4], float* out, int fr) const {
        float A2[4], HE[4];
#pragma unroll
        for (int j = 0; j < 4; ++j) { float P[4], T[4];
#pragma unroll
            for (int m = 0; m < 4; ++m) { P[m] = row_prefix(la[m][j]); T[m] = row_total(la[m][j]); }
            A2[j] = (T[0] + T[1]) + (T[2] + T[3]); float acc = 0.f;
#pragma unroll
            for (int m = 0; m < 4; ++m) { float S;
                if (FWD) { float after = 0.f;
#pragma unroll
                    for (int q = m + 1; q < 4; ++q) after += T[q];
                    S = (T[m] - P[m]) + after; }
                else { float before = 0.f;
#pragma unroll
                    for (int q = 0; q < m; ++q) before += T[q];
                    S = (P[m] - la[m][j]) + before; }
                acc += bb[m][j] * fexp2(S); }
            HE[j] = row_total(acc); }
        if (fr == 0) { *(f32x4*)out = (f32x4){A2[0], A2[1], A2[2], A2[3]}; *(f32x4*)(out + D) = (f32x4){HE[0], HE[1], HE[2], HE[3]}; }
    }
    __device__ __forceinline__ void operator()(const f32x4 (&acc)[2][2][4][2], const Unit& u, int wr, int wc, int fr, int fq) const {
        const int row0 = u.pm * 256 + wr * 64 + fr, ch = u.pn * 64 + wc * 16 + fq * 4;
#pragma unroll
        for (int ai = 0; ai < 2; ++ai) { float laF[4][4], bF[4][4], laB[4][4], bB[4][4];
#pragma unroll
            for (int m = 0; m < 4; ++m) { const size_t ro = (size_t)(row0 + ai * HALF + m * 16) * D + ch;
                const u32x2 xw = *(const u32x2*)(XC + ro);
                one_dir(acc[ai][0][m][0], acc[ai][0][m][1], ba + ch, bx + ch, sp2 + ch, xw, LAF + ro, BF + ro, laF[m], bF[m]);
                one_dir(acc[ai][1][m][0], acc[ai][1][m][1], ba + 1024 + ch, bx + 1024 + ch, sp2 + 1024 + ch, xw, LAB + ro, BB + ro, laB[m], bB[m]); }
            const int sub = u.pm * 4 + ai * 2 + wr;
            agg_dir<true>(laF, bF, AGG + ((size_t)(sub * 2 + 0) * 2) * D + ch, fr);
            agg_dir<false>(laB, bB, AGG + ((size_t)(sub * 2 + 1) * 2) * D + ch, fr); }
    }
};
struct EpiPool {
    static constexpr bool PERM = true; bf16* O; const float* scale;
    __device__ __forceinline__ void operator()(const f32x4 (&acc)[2][2][4][2], const Unit& u, int wr, int wc, int fr, int fq) const {
        const int row0 = u.pm * 256 + wr * 64 + fr, col0 = u.pn * 256 + wc * 32 + 8 * fq;
        f32x4 sv[2][2];
#pragma unroll
        for (int bj = 0; bj < 2; ++bj)
#pragma unroll
            for (int n = 0; n < 2; ++n) sv[bj][n] = *(const f32x4*)(scale + col0 + bj * HALF + 4 * n);
#pragma unroll
        for (int ai = 0; ai < 2; ++ai)
#pragma unroll
            for (int m = 0; m < 4; ++m) { bf16* rowp = O + (size_t)(row0 + ai * HALF + m * 16) * D + col0;
#pragma unroll
                for (int bj = 0; bj < 2; ++bj) { const f32x4 v0 = acc[ai][bj][m][0] * sv[bj][0], v1 = acc[ai][bj][m][1] * sv[bj][1];
                    u32x4 w; w.x = cvt_pk_bf16(v0[0], v0[1]); w.y = cvt_pk_bf16(v0[2], v0[3]); w.z = cvt_pk_bf16(v1[0], v1[1]); w.w = cvt_pk_bf16(v1[2], v1[3]);
                    *(u32x4*)(rowp + bj * HALF) = w; } }
    }
};
struct EpiBranch {
    static constexpr bool PERM = true; bf16* O; const bf16* PROJ;
    __device__ __forceinline__ void operator()(const f32x4 (&acc)[2][2][4][2], const Unit& u, int wr, int wc, int fr, int fq) const {
        const int row0 = u.pm * 256 + wr * 64 + fr, col0 = u.pn * 256 + wc * 32 + 8 * fq; const int which = u.aux;
#pragma unroll
        for (int ai = 0; ai < 2; ++ai)
#pragma unroll
            for (int m = 0; m < 4; ++m) { const int r = row0 + ai * HALF + m * 16; bf16* rowp = O + (size_t)r * D + col0; const bf16* sp = PROJ + (size_t)r * INC + 3072 + which * 1024 + col0;
#pragma unroll
                for (int bj = 0; bj < 2; ++bj) { const u32x4 s = *(const u32x4*)(sp + bj * HALF); const f32x4 a0 = acc[ai][bj][m][0], a1 = acc[ai][bj][m][1];
                    float o[8] = {blo(s.x) * a0[0], bhi(s.x) * a0[1], blo(s.y) * a0[2], bhi(s.y) * a0[3], blo(s.z) * a1[0], bhi(s.z) * a1[1], blo(s.w) * a1[2], bhi(s.w) * a1[3]};
                    if (which) { const u32x4 p = *(const u32x4*)(rowp + bj * HALF); o[0] += blo(p.x); o[1] += bhi(p.x); o[2] += blo(p.y); o[3] += bhi(p.y); o[4] += blo(p.z); o[5] += bhi(p.z); o[6] += blo(p.w); o[7] += bhi(p.w); }
                    u32x4 w; w.x = cvt_pk_bf16(o[0], o[1]); w.y = cvt_pk_bf16(o[2], o[3]); w.z = cvt_pk_bf16(o[4], o[5]); w.w = cvt_pk_bf16(o[6], o[7]);
                    *(u32x4*)(rowp + bj * HALF) = w; } }
    }
};
struct EpiOut {
    static constexpr bool PERM = true; bf16* C;
    __device__ __forceinline__ void operator()(const f32x4 (&acc)[2][2][4][2], const Unit& u, int wr, int wc, int fr, int fq) const {
        const int row0 = u.pm * 256 + wr * 64 + fr, col0 = u.pn * 256 + wc * 32 + 8 * fq;
#pragma unroll
        for (int ai = 0; ai < 2; ++ai)
#pragma unroll
            for (int m = 0; m < 4; ++m) { bf16* rowp = C + (size_t)(row0 + ai * HALF + m * 16) * D + col0;
#pragma unroll
                for (int bj = 0; bj < 2; ++bj) { const f32x4 v0 = acc[ai][bj][m][0], v1 = acc[ai][bj][m][1];
                    u32x4 w; w.x = cvt_pk_bf16(v0[0], v0[1]); w.y = cvt_pk_bf16(v0[2], v0[3]); w.z = cvt_pk_bf16(v1[0], v1[1]); w.w = cvt_pk_bf16(v1[2], v1[3]);
                    *(u32x4*)(rowp + bj * HALF) = w; } }
    }
};
struct EpiMoe1 {
    static constexpr bool PERM = true; unsigned char* O; const float* b1;
    __device__ __forceinline__ void operator()(const f32x4 (&acc)[2][2][4][2], const Unit& u, int wr, int wc, int fr, int fq) const {
        const int row0 = u.pm * 256 + wr * 64 + fr, j0 = u.pn * 128 + wc * 32 + 8 * fq; const float* bp = b1 + (size_t)u.aux * 2048 + j0;
        const f32x4 bg0 = *(const f32x4*)(bp), bg1 = *(const f32x4*)(bp + 4), bl0 = *(const f32x4*)(bp + 1024), bl1 = *(const f32x4*)(bp + 1028);
#pragma unroll
        for (int ai = 0; ai < 2; ++ai)
#pragma unroll
            for (int m = 0; m < 4; ++m) { unsigned char* rowp = O + (size_t)(row0 + ai * HALF + m * 16) * D + j0;
                const f32x4 g0 = acc[ai][0][m][0] + bg0, g1 = acc[ai][0][m][1] + bg1, l0 = acc[ai][1][m][0] + bl0, l1 = acc[ai][1][m][1] + bl1;
                float o[8];
#pragma unroll
                for (int j = 0; j < 4; ++j) { const float ga = fminf(g0[j], 7.0f), la = fminf(fmaxf(l0[j], -7.0f), 7.0f); o[j] = (ga * frcp(1.0f + fexp2(ga * (-1.702f * LOG2E)))) * __builtin_fmaf(la, ACT8SCALE, ACT8SCALE);
                    const float gb = fminf(g1[j], 7.0f), lb = fminf(fmaxf(l1[j], -7.0f), 7.0f); o[4 + j] = (gb * frcp(1.0f + fexp2(gb * (-1.702f * LOG2E)))) * __builtin_fmaf(lb, ACT8SCALE, ACT8SCALE); }
                int w0 = __builtin_amdgcn_cvt_pk_fp8_f32(o[0], o[1], 0, false); w0 = __builtin_amdgcn_cvt_pk_fp8_f32(o[2], o[3], w0, true);
                int w1 = __builtin_amdgcn_cvt_pk_fp8_f32(o[4], o[5], 0, false); w1 = __builtin_amdgcn_cvt_pk_fp8_f32(o[6], o[7], w1, true);
                *(u32x2*)rowp = (u32x2){(unsigned)w0, (unsigned)w1}; }
    }
};
struct EpiMoe2 {
    static constexpr bool PERM = true; unsigned char* O; const float* b2;
    __device__ __forceinline__ void operator()(const f32x4 (&acc)[2][2][4][2], const Unit& u, int wr, int wc, int fr, int fq) const {
        const int row0 = u.pm * 256 + wr * 64 + fr, col0 = u.pn * 256 + wc * 32 + 8 * fq; const float* bp = b2 + (size_t)u.aux * 1024 + col0;
        f32x4 bv[2][2];
#pragma unroll
        for (int bj = 0; bj < 2; ++bj)
#pragma unroll
            for (int n = 0; n < 2; ++n) bv[bj][n] = *(const f32x4*)(bp + bj * HALF + 4 * n);
#pragma unroll
        for (int ai = 0; ai < 2; ++ai)
#pragma unroll
            for (int m = 0; m < 4; ++m) { unsigned char* rowp = O + (size_t)(row0 + ai * HALF + m * 16) * D + col0;
#pragma unroll
                for (int bj = 0; bj < 2; ++bj) { const f32x4 v0 = (acc[ai][bj][m][0] + bv[bj][0]) * O8SCALE, v1 = (acc[ai][bj][m][1] + bv[bj][1]) * O8SCALE;
                    int w0 = __builtin_amdgcn_cvt_pk_fp8_f32(v0[0], v0[1], 0, false); w0 = __builtin_amdgcn_cvt_pk_fp8_f32(v0[2], v0[3], w0, true);
                    int w1 = __builtin_amdgcn_cvt_pk_fp8_f32(v1[0], v1[1], 0, false); w1 = __builtin_amdgcn_cvt_pk_fp8_f32(v1[2], v1[3], w1, true);
                    *(u32x2*)(rowp + bj * HALF) = (u32x2){(unsigned)w0, (unsigned)w1}; } }
    }
};

constexpr int NPHASE = 15;
__global__ void __launch_bounds__(512, 2) mk_fwd(Args a) {
    extern __shared__ __attribute__((aligned(16))) unsigned char lds_raw[];
    Frame F; F.lds = (LAS unsigned char*)lds_raw; F.tid = threadIdx.x; F.lane = F.tid & 63; F.wave = __builtin_amdgcn_readfirstlane(F.tid >> 6); F.G = gridDim.x; F.blk = blockIdx.x;
    volatile LAS unsigned* MISC = (volatile LAS unsigned*)(F.lds + LDS_MISC);
    if (F.tid < 64) MISC[F.tid] = 0u;
    __syncthreads();
    unsigned char* ws = a.ws;
#if MK_MULTI
#define GRID_BAR() do { } while (0)
#else
    XcdBarrier bar = xcd_barrier_post((unsigned*)(ws + WS_CTL) + CW_BAR, MISC + 8);
#define GRID_BAR() xcd_barrier(bar)
#endif
    const int lo = a.ph_lo, hi = a.ph_hi;
#define IN(k) (lo <= (k) && (k) < hi)
#define SEAM(k) do { if (IN((k) + 1)) GRID_BAR(); } while (0)
    LAS unsigned char* ring = F.lds;

#ifndef DUPMASK
#define DUPMASK 0
#endif
#define DUP(k) ((DUPMASK >> (k)) & 1)
#define RUN(k, BODY) do { if (IN(k)) { BODY; if (DUP(k)) { GRID_BAR(); BODY; } SEAM(k); } } while (0)
#define PH0 p0_prologue(F, a)
#define PH1 p1_prenorm(F, a)
#define PH2 do { pg8::Gemm g{(const bf16*)(ws + WS_U), (const bf16*)(ws + WS_WIN), D, D, D}; OrdProj S{F.G, F.blk}; EpiProj E{(bf16*)(ws + WS_PROJ)}; \
        pg8::gemm_phase<EpiProj, OrdProj>(ring, g, S, E); } while (0)
#define PH3 p3_conv_pool(F, a)
#define PH4 do { \
        { pg8::Gemm g{(const bf16*)(ws + WS_XC), (const bf16*)(ws + WS_WG), D, 256, 256}; OrdGates S{F.G, F.blk}; \
          EpiGates E{(const bf16*)(ws + WS_XC), (bf16*)(ws + WS_LAF), (bf16*)(ws + WS_BF), (bf16*)(ws + WS_LAB), (bf16*)(ws + WS_BB), a.in[I_BA], a.in[I_BX], (const float*)(ws + WS_SP2), (float*)(ws + WS_AGG)}; \
          pg8::gemm_phase<EpiGates, OrdGates>(ring, g, S, E); } \
        { pg8::Gemm g{(const bf16*)(ws + WS_DP), (const bf16*)(ws + WS_WP), D, 256, 256}; OrdPool S{F.G, F.blk}; EpiPool E{(bf16*)(ws + WS_YY) + (size_t)ML * D, a.in[I_POOLS]}; \
          pg8::gemm_phase<EpiPool, OrdPool>(ring, g, S, E); } } while (0)
#define PH6 p6_carry(F, a)
#define PH7 p7_scan_out(F, a)
#define PH8 do { pg8::Gemm g{(const bf16*)(ws + WS_YY), (const bf16*)(ws + WS_WPROJ), D, D, D}; OrdBranch S{F.G, F.blk}; EpiBranch E{(bf16*)(ws + WS_MERGED), (const bf16*)(ws + WS_PROJ)}; \
        pg8::gemm_phase<EpiBranch, OrdBranch>(ring, g, S, E); } while (0)
#define PH9 do { pg8::Gemm g{(const bf16*)(ws + WS_MERGED), (const bf16*)(ws + WS_WOUT), D, D, D}; OrdOut S{F.G, F.blk}; EpiOut E{(bf16*)(ws + WS_MLAT)}; \
        pg8::gemm_phase<EpiOut, OrdOut>(ring, g, S, E); } while (0)
#define PH10 p10_post_mix_route(F, a)
#define PH12 do { build_tile_table(F, a); const LAS int* tab = (const LAS int*)(F.lds + LDS_TAB); \
        pg8::Gemm g{(const bf16*)(ws + WS_VB), (const bf16*)(ws + WS_W1T), D, D, D}; OrdMoe<8, true> S{F.G, F.blk, tab, __builtin_amdgcn_readfirstlane(tab[300])}; EpiMoe1 E{(unsigned char*)(ws + WS_ACT), a.in[I_B1]}; \
        pg8::gemm_phase8<EpiMoe1, OrdMoe<8, true>, true>(ring, g, S, E, SC_ONE, SC_W8, (const int*)(ws + WS_TOKL)); } while (0)
#define PH13 do { build_tile_table(F, a); const LAS int* tab = (const LAS int*)(F.lds + LDS_TAB); \
        pg8::Gemm g{(const bf16*)(ws + WS_ACT), (const bf16*)(ws + WS_W2T), D, D, D}; OrdMoe<4, false> S{F.G, F.blk, tab, __builtin_amdgcn_readfirstlane(tab[300])}; EpiMoe2 E{(unsigned char*)(ws + WS_APERM), a.in[I_B2]}; \
        pg8::gemm_phase8<EpiMoe2, OrdMoe<4, false>>(ring, g, S, E, SC_ACT8, SC_W8); } while (0)
#define PH14 do { build_tile_table(F, a); p14_final(F, a); } while (0)
#ifndef BARX
#define BARX 0
#endif
    if (IN(0)) { PH0; }
    RUN(1, PH1); RUN(2, PH2); RUN(3, PH3); RUN(4, PH4); RUN(6, PH6); RUN(7, PH7);
    RUN(8, PH8); RUN(9, PH9);
    if (IN(10)) { const int nrep10 = DUP(10) ? 2 : 1;
#pragma nounroll
        for (int rep = 0; rep < nrep10; ++rep) { if (rep) GRID_BAR(); p10_post_mix_route(F, a, rep); } SEAM(10); }
 RUN(12, PH12); RUN(13, PH13);
    if (IN(14)) { PH14; if (DUP(14)) { GRID_BAR(); PH14; } }
#undef IN
#undef SEAM
}

extern "C" void kernel_launch(void* const* d_in, const int* in_sizes, int n_in, void* d_out, int out_size, void* d_ws, size_t ws_size, hipStream_t stream) {
    static int grid = 0;
    if (grid == 0) {
        if (n_in != 29 || out_size != ML * D || ws_size < WS_END) { fprintf(stderr, "kernel_launch: unexpected shapes (n_in %d out %d ws %zu)\n", n_in, out_size, ws_size); grid = -1; return; }
        int dev = 0, cus = 0, per_cu = 0;
        if (hipGetDevice(&dev) != hipSuccess || hipDeviceGetAttribute(&cus, hipDeviceAttributeMultiprocessorCount, dev) != hipSuccess) { grid = -1; return; }
        if (hipFuncSetAttribute((const void*)mk_fwd, hipFuncAttributeMaxDynamicSharedMemorySize, LDS_BYTES) != hipSuccess) { fprintf(stderr, "kernel_launch: hipFuncSetAttribute failed\n"); grid = -1; return; }
        if (hipOccupancyMaxActiveBlocksPerMultiprocessor(&per_cu, (const void*)mk_fwd, 512, LDS_BYTES) != hipSuccess || per_cu < 1) { fprintf(stderr, "kernel_launch: occupancy query says %d\n", per_cu); }
        (void)hipGetLastError();
        grid = cus < 256 ? cus : 256;
    }
    if (grid < 0) return;
    (void)hipMemsetAsync((char*)d_ws + WS_CTL, 0, CTL_ZERO_BYTES, stream);
    Args a{};
    for (int i = 0; i < 29; ++i) a.in[i] = (const float*)d_in[i];
    a.out = (float*)d_out; a.ws = (unsigned char*)d_ws;
#if MK_MULTI
    for (int p = 0; p < NPHASE; ++p) { a.ph_lo = p; a.ph_hi = p + 1; hipLaunchKernelGGL(mk_fwd, dim3(grid), dim3(512), LDS_BYTES, stream, a); }
#else
    a.ph_lo = 0; a.ph_hi = NPHASE;
    hipLaunchKernelGGL(mk_fwd, dim3(grid), dim3(512), LDS_BYTES, stream, a);
#endif
}
```

```cpp
#include <hip/hip_runtime.h>
#include <cstdio>
#include <cstdint>

#ifndef MK_MULTI
#define MK_MULTI 0
#endif

#define GAS __attribute__((address_space(1)))
#define LAS __attribute__((address_space(3)))
typedef unsigned short bf16;
typedef float f32x4 __attribute__((ext_vector_type(4)));
typedef float f32x2 __attribute__((ext_vector_type(2)));
typedef unsigned u32x4 __attribute__((ext_vector_type(4)));
typedef unsigned u32x2 __attribute__((ext_vector_type(2)));
typedef short bf16x8 __attribute__((ext_vector_type(8)));
typedef float f32x16 __attribute__((ext_vector_type(16)));


constexpr int D = 1024, SEQ = 8192, NB = 2, ML = NB * SEQ  , CTXL = 256, MC = NB * CTXL  , MT = ML + MC  ;
constexpr int INC = 5120, NE = 32, DFF = 1024;
constexpr int NSUB_L = ML / 64  , NSUB_C = MC / 64  , NSUB = NSUB_L + NSUB_C;
constexpr int MAXTILES = 288, NPAIR = ML * 4;
constexpr float EPS = 1e-6f;
constexpr float LOG2E = 1.4426950408889634f;
constexpr float W8SCALE = 64.0f, ACT8SCALE = 4.0f, O8SCALE = 16.0f, O8INV = 1.0f / 16.0f;
constexpr int SC_ONE = 0x7f7f7f7f, SC_W8 = 0x79797979  , SC_ACT8 = 0x7d7d7d7d  ;

constexpr size_t MiB = 1u << 20;
constexpr size_t WS_CTL = 0, CTL_ZERO_BYTES = 64 * 1024;
constexpr size_t WS_MOD = 1 * MiB;
constexpr size_t WS_SP2 = 1 * MiB + 128 * 1024;
constexpr size_t WS_WRT = 2 * MiB;
constexpr size_t WS_PAIR_E = 3 * MiB, WS_PAIR_W = WS_PAIR_E + 256 * 1024, WS_PAIR_POS = WS_PAIR_W + 256 * 1024, WS_PAIR_SLOT = WS_PAIR_POS + 256 * 1024;
constexpr size_t WS_AGG = 4 * MiB;
constexpr size_t WS_CARRY = 9 * MiB;
constexpr size_t WS_WIN = 12 * MiB;
constexpr size_t WS_WG = 22 * MiB;
constexpr size_t WS_WP = 30 * MiB;
constexpr size_t WS_WPROJ = 31 * MiB;
constexpr size_t WS_WOUT = 35 * MiB;
constexpr size_t WS_W1T = 40 * MiB;
constexpr size_t WS_W2T = 168 * MiB;
constexpr size_t WS_U = 232 * MiB;
constexpr size_t WS_PROJ = 265 * MiB;
constexpr size_t WS_XC = 430 * MiB;
constexpr size_t WS_DP = 463 * MiB;
constexpr size_t WS_LAF = 495 * MiB, WS_BF = 528 * MiB, WS_LAB = 561 * MiB, WS_BB = 594 * MiB;
constexpr size_t WS_YY = 627 * MiB;
constexpr size_t WS_MERGED = 691 * MiB;
constexpr size_t WS_MLAT = 723 * MiB;
constexpr size_t WS_VB = 787 * MiB;
constexpr size_t WS_X1 = 819 * MiB;
constexpr size_t WS_TOKL = 883 * MiB;
constexpr size_t WS_END = 885 * MiB;
constexpr size_t WS_APERM = 232 * MiB;
constexpr size_t WS_ACT = 376 * MiB;
static_assert(WS_APERM + (size_t)MAXTILES * 256 * 1024 * 2 <= WS_ACT && WS_ACT + (size_t)MAXTILES * 256 * 1024 * 2 <= WS_YY, "moe overlay");
constexpr int CW_BAR = 1024;
constexpr int CW_MODFLAG = 6144;
constexpr int CW_TILEQ = 6208;
constexpr int CW_GCNT = 8192;

constexpr int RING_BYTES = 131072;
constexpr int LDS_UP = 132096;
constexpr int LDS_MISC = LDS_UP;
constexpr int LDS_TAB = LDS_UP + 1024;
constexpr int LDS_CNT = LDS_UP + 4096;
constexpr int LDS_LGT = LDS_UP + 8192;
constexpr int LDS_BYTES = 147456;
static_assert(LDS_LGT + 32 * 33 * 4 <= LDS_BYTES, "lds map");

__device__ __forceinline__ float blo(unsigned w) { return __uint_as_float(w << 16); }
__device__ __forceinline__ float bhi(unsigned w) { return __uint_as_float(w & 0xffff0000u); }
__device__ __forceinline__ float bf2f(bf16 h) { return __uint_as_float(((unsigned)h) << 16); }
__device__ __forceinline__ unsigned cvt_pk_bf16(float lo, float hi) { unsigned r; asm volatile("v_cvt_pk_bf16_f32 %0, %1, %2" : "=v"(r) : "v"(lo), "v"(hi)); return r; }
__device__ __forceinline__ float fexp2(float x) { return __builtin_amdgcn_exp2f(x); }
__device__ __forceinline__ float frcp(float x) { return __builtin_amdgcn_rcpf(x); }
__device__ __forceinline__ float sigmoidf_(float x) { return frcp(1.0f + fexp2(-LOG2E * x)); }
__device__ __forceinline__ float gelu_tanh_(float x) { const float t = x * (1.0f + 0.044715f * x * x); return x * frcp(1.0f + fexp2(-2.0f * 0.7978845608028654f * LOG2E * t)); }
template <int CTRL, int ROWMASK> __device__ __forceinline__ float dpp_mov0(float v) { return __builtin_bit_cast(float, __builtin_amdgcn_update_dpp(0, __builtin_bit_cast(int, v), CTRL, ROWMASK, 0xF, false)); }
__device__ __forceinline__ float wave_sum(float v) {
    v += dpp_mov0<0xB1, 0xF>(v);
    v += dpp_mov0<0x4E, 0xF>(v);
    v += dpp_mov0<0x141, 0xF>(v);
    v += dpp_mov0<0x140, 0xF>(v);
    v += dpp_mov0<0x142, 0xA>(v);
    v += dpp_mov0<0x143, 0xC>(v);
    return __builtin_bit_cast(float, __builtin_amdgcn_readlane(__builtin_bit_cast(int, v), 63));
}
#define LDS_WAIT() asm volatile("s_waitcnt lgkmcnt(0)" ::: "memory")
#define VM_WAIT() asm volatile("s_waitcnt vmcnt(0)" ::: "memory")

namespace pg8 {
constexpr int BM = 256, BK = 64, HALF = 128, HTB = HALF * BK * 2, STAGE_BYTES = 8 * HTB, NXCD = 8, WGM = 4;
__host__ __device__ __forceinline__ int lds_byte(int r, int c) { const int st = (r >> 4) * 2 + (c >> 5), rr = r & 15, cc = c & 31, ob = rr * 64 + cc * 2; return st * 1024 + (ob ^ (((ob >> 9) & 1) << 5)); }
__host__ __device__ __forceinline__ void stage_rc(int b, int& R, int& C) { const int st = b / 1024, sb = b % 1024, swz = sb ^ (((sb >> 9) & 1) << 5); R = (st >> 1) * 16 + swz / 64; C = (st & 1) * 32 + (swz % 64) / 2; }
__host__ __device__ __forceinline__ int perm32(int rho) { const int n = rho >> 4, i = rho & 15; return 8 * (i >> 2) + 4 * n + (i & 3); }

struct Unit { size_t aoff, boff; int pm, pn, aux; };
struct Gemm { const bf16* A; const bf16* Bt; int lda, ldb, K; };

__host__ __device__ __forceinline__ void tile_order(int L, int nM, int nN, int& pm, int& pn) {
    const int nwg = nM * nN; int wgid = L; { const int q = nwg / NXCD, r = nwg % NXCD, xcd = wgid % NXCD, off = wgid / NXCD; wgid = (xcd < r ? xcd * (q + 1) : r * (q + 1) + (xcd - r) * q) + off; }
    const int nig = WGM * nN, gid = wgid / nig, fm = gid * WGM, gsz = (nM - fm) < WGM ? (nM - fm) : WGM;
    pm = fm + ((wgid % nig) % gsz); pn = (wgid % nig) / gsz;
}

template <class Epi, class Sched, bool ALIGN_EPI = true>
__device__ __forceinline__ void gemm_phase(LAS unsigned char* lds, const Gemm g, const Sched& S, const Epi& E) {
    const int tid = threadIdx.x, wid = __builtin_amdgcn_readfirstlane(tid >> 6), lane = tid & 63, wr = wid >> 2, wc = wid & 3, fr = lane & 15, fq = lane >> 4;
    const int K = g.K, nt = K / BK;
    unsigned voffA[2], voffB[2];
#pragma unroll
    for (int i = 0; i < 2; ++i) { int R, C; stage_rc(tid * 16 + i * 8192, R, C); const int Rb = Epi::PERM ? ((R & ~31) + perm32(R & 31)) : R;
        voffA[i] = (unsigned)(R * g.lda + C) * 2u; voffB[i] = (unsigned)(Rb * g.ldb + C) * 2u; }
    const size_t kstep = (size_t)(BK * 2);
    const size_t hstepA = (size_t)HALF * g.lda * 2, hstepB = (size_t)HALF * g.ldb * 2;
    const unsigned ldsw = (unsigned)wid * 1024u;
    const int aoff = lds_byte(wr * 64 + fr, fq * 8), boff = lds_byte(wc * 32 + fr, fq * 8);
#define PG8_SA(b, h) (((b) * 2 + (h)) * HTB)
#define PG8_SB(b, h) ((4 + (b) * 2 + (h)) * HTB)
#define PG8_STAGE(bufoff, gbase, voff) do { _Pragma("unroll") for (int _i = 0; _i < 2; ++_i) \
        __builtin_amdgcn_global_load_lds((const unsigned*)((const char*)(gbase) + (voff)[_i]), (LAS unsigned*)(lds + (bufoff) + ldsw + _i * 8192), 16, 0, 0); } while (0)
#define PG8_LDA(dst, b, h) do { _Pragma("unroll") for (int m = 0; m < 4; ++m) _Pragma("unroll") for (int k = 0; k < 2; ++k) dst[m][k] = *(const LAS bf16x8*)(lds + PG8_SA(b, h) + aoff + m * 2048 + k * 1024); } while (0)
#define PG8_LDB(dst, b, h) do { _Pragma("unroll") for (int n = 0; n < 2; ++n) _Pragma("unroll") for (int k = 0; k < 2; ++k) dst[n][k] = *(const LAS bf16x8*)(lds + PG8_SB(b, h) + boff + n * 2048 + k * 1024); } while (0)
#define PG8_MMA(ai, bj, At, Bt) do { __builtin_amdgcn_s_setprio(1); _Pragma("unroll") for (int m = 0; m < 4; ++m) _Pragma("unroll") for (int n = 0; n < 2; ++n) _Pragma("unroll") for (int k = 0; k < 2; ++k) \
        acc[ai][bj][m][n] = __builtin_amdgcn_mfma_f32_16x16x32_bf16(Bt[n][k], At[m][k], acc[ai][bj][m][n], 0, 0, 0); __builtin_amdgcn_s_setprio(0); } while (0)
#define PG8_WAIT_V(n) asm volatile("s_waitcnt vmcnt(" #n ")" ::: "memory")
#define PG8_WAIT_L(n) asm volatile("s_waitcnt lgkmcnt(" #n ")" ::: "memory")
#define PG8_BAR __builtin_amdgcn_s_barrier()
#define PG8_SCHED __builtin_amdgcn_sched_barrier(0)
    Unit cur, nxt; int ui = 0;
    if (!S.next(0, cur)) return;
    f32x4 acc[2][2][4][2];
#pragma unroll
    for (int a = 0; a < 2; ++a)
#pragma unroll
        for (int b = 0; b < 2; ++b)
#pragma unroll
            for (int m = 0; m < 4; ++m)
#pragma unroll
                for (int n = 0; n < 2; ++n) acc[a][b][m][n] = (f32x4){0.f, 0.f, 0.f, 0.f};
    bf16x8 At[4][2], B0[2][2], B1[2][2];
    const char* cA = (const char*)g.A + cur.aoff; const char* cB = (const char*)g.Bt + cur.boff;
    PG8_STAGE(PG8_SB(0, 0), cB, voffB); PG8_STAGE(PG8_SB(0, 1), cB + hstepB, voffB); PG8_STAGE(PG8_SA(0, 0), cA, voffA); PG8_STAGE(PG8_SA(0, 1), cA + hstepA, voffA);
    if (wr == 1) PG8_BAR;
    PG8_WAIT_V(2); PG8_BAR;
    PG8_STAGE(PG8_SB(1, 0), cB + kstep, voffB); PG8_STAGE(PG8_SA(1, 0), cA + kstep, voffA); PG8_STAGE(PG8_SB(1, 1), cB + hstepB + kstep, voffB);
    PG8_WAIT_V(6); PG8_BAR;
    for (;;) {
        const bool has_next = S.next(ui + 1, nxt);
        const char* nA = has_next ? (const char*)g.A + nxt.aoff : cA; const char* nB = has_next ? (const char*)g.Bt + nxt.boff : cB;
#pragma nounroll
        for (int t = 0; t < nt; t += 2) {
            const bool last = (t == nt - 2);
            const char* a1 = cA + (size_t)(t + 1) * kstep;
            const char* a2 = last ? nA : cA + (size_t)(t + 2) * kstep; const char* b2 = last ? nB : cB + (size_t)(t + 2) * kstep;
            const char* a3 = a2 + kstep; const char* b3 = b2 + kstep;
            PG8_LDB(B0, 0, 0); PG8_LDB(B1, 0, 1); PG8_SCHED; PG8_LDA(At, 0, 0); PG8_STAGE(PG8_SA(1, 1), a1 + hstepA, voffA);
            PG8_WAIT_V(8); PG8_WAIT_L(0); PG8_BAR; PG8_MMA(0, 0, At, B0); PG8_MMA(0, 1, At, B1); PG8_BAR; PG8_SCHED;
            PG8_LDA(At, 0, 1); PG8_STAGE(PG8_SB(0, 0), b2, voffB); PG8_STAGE(PG8_SB(0, 1), b2 + hstepB, voffB); PG8_STAGE(PG8_SA(0, 0), a2, voffA);
            PG8_WAIT_V(8); PG8_WAIT_L(0); PG8_BAR; PG8_MMA(1, 0, At, B0); PG8_MMA(1, 1, At, B1); PG8_BAR; PG8_SCHED;
            PG8_LDB(B0, 1, 0); PG8_LDB(B1, 1, 1); PG8_SCHED; PG8_LDA(At, 1, 0); PG8_STAGE(PG8_SA(0, 1), a2 + hstepA, voffA);
            PG8_WAIT_V(8); PG8_WAIT_L(0); PG8_BAR; PG8_MMA(0, 0, At, B0); PG8_MMA(0, 1, At, B1); PG8_BAR; PG8_SCHED;
            PG8_LDA(At, 1, 1); PG8_STAGE(PG8_SB(1, 0), b3, voffB); PG8_STAGE(PG8_SB(1, 1), b3 + hstepB, voffB); PG8_STAGE(PG8_SA(1, 0), a3, voffA);
            PG8_WAIT_V(8); PG8_WAIT_L(0); PG8_BAR; PG8_MMA(1, 0, At, B0); PG8_MMA(1, 1, At, B1); PG8_BAR; PG8_SCHED;
        }
        if constexpr (ALIGN_EPI) { if (wr == 0) PG8_BAR; }
        E(acc, cur, wr, wc, fr, fq);
        if (!has_next) break;
#pragma unroll
        for (int a = 0; a < 2; ++a)
#pragma unroll
            for (int b = 0; b < 2; ++b)
#pragma unroll
                for (int m = 0; m < 4; ++m)
#pragma unroll
                    for (int n = 0; n < 2; ++n) acc[a][b][m][n] = (f32x4){0.f, 0.f, 0.f, 0.f};
        cur = nxt; cA = nA; cB = nB; ++ui;
        if constexpr (ALIGN_EPI) { if (wr == 1) PG8_BAR; }
    }
    PG8_WAIT_V(0);
    if constexpr (!ALIGN_EPI) { if (wr == 0) PG8_BAR; }
    PG8_BAR;
#undef PG8_SA
#undef PG8_SB
#undef PG8_STAGE
#undef PG8_LDA
#undef PG8_LDB
#undef PG8_MMA
#undef PG8_WAIT_V
#undef PG8_WAIT_L
#undef PG8_BAR
#undef PG8_SCHED
}
__host__ __device__ __forceinline__ int lds_byte8(int r, int cb) { const int st = (r >> 4) * 2 + (cb >> 6), rr = r & 15, ob = rr * 64 + (cb & 63); return st * 1024 + (ob ^ (((ob >> 9) & 1) << 4)); }
__host__ __device__ __forceinline__ void stage_rc8(int b, int& R, int& Cb) { const int st = b / 1024, sb = b % 1024, swz = sb ^ (((sb >> 9) & 1) << 4); R = (st >> 1) * 16 + swz / 64; Cb = (st & 1) * 64 + (swz % 64); }
typedef int i32x4 __attribute__((ext_vector_type(4)));
typedef int i32x8 __attribute__((ext_vector_type(8)));
template <class Epi, class Sched, bool GATHER = false, bool ALIGN_EPI = true>
__device__ __forceinline__ void gemm_phase8(LAS unsigned char* lds, const Gemm g, const Sched& S, const Epi& E, const int scaleA, const int scaleB, const int* __restrict__ rowlist = nullptr) {
    const int tid = threadIdx.x, wid = __builtin_amdgcn_readfirstlane(tid >> 6), lane = tid & 63, wr = wid >> 2, wc = wid & 3, fr = lane & 15, fq = lane >> 4;
    const int K = g.K, nt = K / 128;
    unsigned voffA[2], voffB[2], gC[2]; int gR[2];
#pragma unroll
    for (int i = 0; i < 2; ++i) { int R, C; stage_rc8(tid * 16 + i * 8192, R, C); const int Rb = Epi::PERM ? ((R & ~31) + perm32(R & 31)) : R;
        voffA[i] = (unsigned)(R * g.lda + C); voffB[i] = (unsigned)(Rb * g.ldb + C); gR[i] = R; gC[i] = (unsigned)C; }
    const size_t kstep = (size_t)128;
    const size_t hstepA = (size_t)HALF * g.lda, hstepB = (size_t)HALF * g.ldb;
    const unsigned ldsw = (unsigned)wid * 1024u;
    const int aoff0 = lds_byte8(wr * 64 + fr, fq * 32), aoff1 = lds_byte8(wr * 64 + fr, fq * 32 + 16), boff0 = lds_byte8(wc * 32 + fr, fq * 32), boff1 = lds_byte8(wc * 32 + fr, fq * 32 + 16);
#define PG8_SA(b, h) (((b) * 2 + (h)) * HTB)
#define PG8_SB(b, h) ((4 + (b) * 2 + (h)) * HTB)
#define PG8_STAGE(bufoff, gbase, voff) do { _Pragma("unroll") for (int _i = 0; _i < 2; ++_i) \
        __builtin_amdgcn_global_load_lds((const unsigned*)((const char*)(gbase) + (voff)[_i]), (LAS unsigned*)(lds + (bufoff) + ldsw + _i * 8192), 16, 0, 0); } while (0)
#define PG8_LDA(dst, b, h) do { _Pragma("unroll") for (int m = 0; m < 4; ++m) { dst[m].lo = *(const LAS i32x4*)(lds + PG8_SA(b, h) + aoff0 + m * 2048); dst[m].hi = *(const LAS i32x4*)(lds + PG8_SA(b, h) + aoff1 + m * 2048); } } while (0)
#define PG8_LDB(dst, b, h) do { _Pragma("unroll") for (int n = 0; n < 2; ++n) { dst[n].lo = *(const LAS i32x4*)(lds + PG8_SB(b, h) + boff0 + n * 2048); dst[n].hi = *(const LAS i32x4*)(lds + PG8_SB(b, h) + boff1 + n * 2048); } } while (0)
#define PG8_MMA(ai, bj, At, Bt) do { __builtin_amdgcn_s_setprio(1); _Pragma("unroll") for (int m = 0; m < 4; ++m) _Pragma("unroll") for (int n = 0; n < 2; ++n) \
        asm volatile("v_mfma_scale_f32_16x16x128_f8f6f4 %0, %1, %2, %0, %3, %4 op_sel_hi:[0,0,0]" : "+v"(acc[ai][bj][m][n]) : "v"(Bt[n]), "v"(At[m]), "v"(scaleB), "v"(scaleA)); __builtin_amdgcn_s_setprio(0); } while (0)
#define PG8_WAIT_V(n) asm volatile("s_waitcnt vmcnt(" #n ")" ::: "memory")
#define PG8_WAIT_L(n) asm volatile("s_waitcnt lgkmcnt(" #n ")" ::: "memory")
#define PG8_BAR __builtin_amdgcn_s_barrier()
#define PG8_SCHED __builtin_amdgcn_sched_barrier(0)
    unsigned vC[2][2], vN[2][2]; int ixn[2][2];
#define PG8_IDX_ISSUE(u_) do { if constexpr (GATHER) { const int nv_ = (int)((u_).aoff >> 32); const int* lp_ = rowlist + (unsigned)((u_).aoff); \
        _Pragma("unroll") for (int h_ = 0; h_ < 2; ++h_) _Pragma("unroll") for (int i_ = 0; i_ < 2; ++i_) { int rr_ = h_ * 128 + gR[i_]; rr_ = rr_ < nv_ ? rr_ : nv_ - 1; \
            asm volatile("global_load_dword %0, %1, off" : "=v"(ixn[h_][i_]) : "v"(lp_ + rr_) : "memory"); } } } while (0)
#define PG8_IDX_USE() do { if constexpr (GATHER) { asm volatile("" : "+v"(ixn[0][0]), "+v"(ixn[0][1]), "+v"(ixn[1][0]), "+v"(ixn[1][1])); \
        _Pragma("unroll") for (int h_ = 0; h_ < 2; ++h_) _Pragma("unroll") for (int i_ = 0; i_ < 2; ++i_) vN[h_][i_] = (unsigned)ixn[h_][i_] * (unsigned)g.lda + gC[i_]; } } while (0)
#define PG8_STAGE_A(bufoff, kptr, h, useN) do { if constexpr (GATHER) { _Pragma("unroll") for (int _i = 0; _i < 2; ++_i) { const unsigned vo_ = (useN) ? vN[h][_i] : vC[h][_i]; \
        __builtin_amdgcn_global_load_lds((const unsigned*)((const char*)(kptr) + vo_), (LAS unsigned*)(lds + (bufoff) + ldsw + _i * 8192), 16, 0, 0); } } \
        else { PG8_STAGE(bufoff, (const char*)(kptr) + (h) * hstepA, voffA); } } while (0)
    Unit cur, nxt; int ui = 0;
    if (!S.next(0, cur)) return;
    f32x4 acc[2][2][4][2];
#pragma unroll
    for (int a = 0; a < 2; ++a)
#pragma unroll
        for (int b = 0; b < 2; ++b)
#pragma unroll
            for (int m = 0; m < 4; ++m)
#pragma unroll
                for (int n = 0; n < 2; ++n) acc[a][b][m][n] = (f32x4){0.f, 0.f, 0.f, 0.f};
    i32x8 At[4], B0[2], B1[2];
    const char* cA = GATHER ? (const char*)g.A : (const char*)g.A + cur.aoff; const char* cB = (const char*)g.Bt + cur.boff;
    if constexpr (GATHER) { PG8_IDX_ISSUE(cur); PG8_WAIT_V(0); PG8_IDX_USE();
#pragma unroll
        for (int h_ = 0; h_ < 2; ++h_)
#pragma unroll
            for (int i_ = 0; i_ < 2; ++i_) vC[h_][i_] = vN[h_][i_]; }
    PG8_STAGE(PG8_SB(0, 0), cB, voffB); PG8_STAGE(PG8_SB(0, 1), cB + hstepB, voffB); PG8_STAGE_A(PG8_SA(0, 0), cA, 0, false); PG8_STAGE_A(PG8_SA(0, 1), cA, 1, false);
    if (wr == 1) PG8_BAR;
    PG8_WAIT_V(2); PG8_BAR;
    PG8_STAGE(PG8_SB(1, 0), cB + kstep, voffB); PG8_STAGE_A(PG8_SA(1, 0), cA + kstep, 0, false); PG8_STAGE(PG8_SB(1, 1), cB + hstepB + kstep, voffB);
    PG8_WAIT_V(6); PG8_BAR;
    for (;;) {
        const bool has_next = S.next(ui + 1, nxt);
        const char* nA = GATHER ? (const char*)g.A : (has_next ? (const char*)g.A + nxt.aoff : cA); const char* nB = has_next ? (const char*)g.Bt + nxt.boff : cB;
        if (has_next) PG8_IDX_ISSUE(nxt);
#pragma nounroll
        for (int t = 0; t < nt; t += 2) {
            const bool last = (t == nt - 2);
            const char* a1 = cA + (size_t)(t + 1) * kstep;
            const char* a2 = last ? nA : cA + (size_t)(t + 2) * kstep; const char* b2 = last ? nB : cB + (size_t)(t + 2) * kstep;
            const char* a3 = a2 + kstep; const char* b3 = b2 + kstep;
            const bool useN = GATHER && last && has_next;
            if (last) { if (has_next) { PG8_IDX_USE(); } }
            PG8_LDB(B0, 0, 0); PG8_LDB(B1, 0, 1); PG8_SCHED; PG8_LDA(At, 0, 0); PG8_STAGE_A(PG8_SA(1, 1), a1, 1, false);
            PG8_WAIT_V(8); PG8_WAIT_L(0); PG8_BAR; PG8_MMA(0, 0, At, B0); PG8_MMA(0, 1, At, B1); PG8_BAR; PG8_SCHED;
            PG8_LDA(At, 0, 1); PG8_STAGE(PG8_SB(0, 0), b2, voffB); PG8_STAGE(PG8_SB(0, 1), b2 + hstepB, voffB); PG8_STAGE_A(PG8_SA(0, 0), a2, 0, useN);
            PG8_WAIT_V(8); PG8_WAIT_L(0); PG8_BAR; PG8_MMA(1, 0, At, B0); PG8_MMA(1, 1, At, B1); PG8_BAR; PG8_SCHED;
            PG8_LDB(B0, 1, 0); PG8_LDB(B1, 1, 1); PG8_SCHED; PG8_LDA(At, 1, 0); PG8_STAGE_A(PG8_SA(0, 1), a2, 1, useN);
            PG8_WAIT_V(8); PG8_WAIT_L(0); PG8_BAR; PG8_MMA(0, 0, At, B0); PG8_MMA(0, 1, At, B1); PG8_BAR; PG8_SCHED;
            PG8_LDA(At, 1, 1); PG8_STAGE(PG8_SB(1, 0), b3, voffB); PG8_STAGE(PG8_SB(1, 1), b3 + hstepB, voffB); PG8_STAGE_A(PG8_SA(1, 0), a3, 0, useN);
            PG8_WAIT_V(8); PG8_WAIT_L(0); PG8_BAR; PG8_MMA(1, 0, At, B0); PG8_MMA(1, 1, At, B1); PG8_BAR; PG8_SCHED;
        }
        if constexpr (ALIGN_EPI) { if (wr == 0) PG8_BAR; }
        asm volatile("s_nop 15\n\ts_nop 15" ::: "memory");
        E(acc, cur, wr, wc, fr, fq);
        if (!has_next) break;
#pragma unroll
        for (int a = 0; a < 2; ++a)
#pragma unroll
            for (int b = 0; b < 2; ++b)
#pragma unroll
                for (int m = 0; m < 4; ++m)
#pragma unroll
                    for (int n = 0; n < 2; ++n) acc[a][b][m][n] = (f32x4){0.f, 0.f, 0.f, 0.f};
        cur = nxt; cA = nA; cB = nB; ++ui;
        if constexpr (GATHER) {
#pragma unroll
            for (int h_ = 0; h_ < 2; ++h_)
#pragma unroll
                for (int i_ = 0; i_ < 2; ++i_) vC[h_][i_] = vN[h_][i_]; }
        if constexpr (ALIGN_EPI) { if (wr == 1) PG8_BAR; }
    }
    PG8_WAIT_V(0);
    if constexpr (!ALIGN_EPI) { if (wr == 0) PG8_BAR; }
    PG8_BAR;
#undef PG8_IDX_ISSUE
#undef PG8_IDX_USE
#undef PG8_STAGE_A
#undef PG8_SA
#undef PG8_SB
#undef PG8_STAGE
#undef PG8_LDA
#undef PG8_LDB
#undef PG8_MMA
#undef PG8_WAIT_V
#undef PG8_WAIT_L
#undef PG8_BAR
#undef PG8_SCHED
}
}

#define XB_TMO      128
#define XB_XCNT(j)  (256  + 64 * (j))
#define XB_XSUB(j)  (1280 + 64 * (j))
#define XB_XGEN(j)  (2304 + 64 * (j))
#define XB_TOP      3328
#define XB_TOPGEN   3392
#define XCD_BAR_WORDS 3456
#define XB_SPIN_CAP (1u << 18)
__device__ __forceinline__ unsigned xb_ld(unsigned* p)              { return __hip_atomic_load(p, __ATOMIC_RELAXED, __HIP_MEMORY_SCOPE_AGENT); }
__device__ __forceinline__ unsigned xb_add(unsigned* p, unsigned v) { return __hip_atomic_fetch_add(p, v, __ATOMIC_RELAXED, __HIP_MEMORY_SCOPE_AGENT); }
__device__ __forceinline__ unsigned xb_xcc_id() { return (unsigned)__builtin_amdgcn_s_getreg((3 << 11) | 20) & 0xFu; }
#define XB_SPIN(cond, bar) do { unsigned _sp = 0; while (cond) { __builtin_amdgcn_s_sleep(1); \
    if ((++_sp & 255u) == 0u) { if (xb_ld(&(bar)[XB_TMO])) break; if (_sp > XB_SPIN_CAP) { atomicAdd(&(bar)[XB_TMO], 1u); break; } } } } while (0)
struct XcdBarrier { unsigned* bar; unsigned x; volatile LAS unsigned* st; };
__device__ __forceinline__ XcdBarrier xcd_barrier_post(unsigned* bar, volatile LAS unsigned* st) {
    XcdBarrier b; b.bar = bar; b.x = xb_xcc_id(); b.st = st;
    if (threadIdx.x == 0) (void)xb_add(&bar[XB_XCNT(b.x)], 1u);
    return b;
}
__device__ __forceinline__ void xcd_barrier_complete(unsigned* bar, unsigned x, unsigned& nloc, unsigned& nx) {
    const unsigned G = gridDim.x * gridDim.y * gridDim.z;
    unsigned sum, cnt, mine, sp = 0u;
    for (;;) {
        sum = 0u; cnt = 0u; mine = 0u;
#pragma unroll
        for (unsigned j = 0; j < 16; ++j) { const unsigned c = xb_ld(&bar[XB_XCNT(j)]); sum += c; cnt += (c > 0u) ? 1u : 0u; mine = (j == x) ? c : mine; }
        if (sum == G) break;
        __builtin_amdgcn_s_sleep(1);
        if ((++sp & 255u) == 0u) { if (xb_ld(&bar[XB_TMO])) break; if (sp > XB_SPIN_CAP) { atomicAdd(&bar[XB_TMO], 1u); break; } }
    }
    nloc = mine > 0u ? mine : 1u; nx = cnt > 0u ? cnt : 1u;
}
__device__ __forceinline__ void xcd_barrier(const XcdBarrier& b) {
    asm volatile("s_waitcnt vmcnt(0)" ::: "memory");
    __syncthreads();
    if (threadIdx.x == 0) {
        unsigned* bar = b.bar;
        __builtin_amdgcn_s_waitcnt(0);
        unsigned nloc = b.st[0], nx = b.st[1];
        if (nloc == 0u) { xcd_barrier_complete(bar, b.x, nloc, nx); b.st[0] = nloc; b.st[1] = nx; }
        const unsigned old = xb_add(&bar[XB_XSUB(b.x)], 1u);
        const unsigned gen = old / nloc;
        if (old + 1u == (gen + 1u) * nloc) {
            __builtin_amdgcn_fence(__ATOMIC_RELEASE, "agent");
            asm volatile("s_waitcnt vmcnt(0)" ::: "memory");
            const unsigned og = xb_add(&bar[XB_TOP], 1u);
            const unsigned tg = og / nx;
            if (og + 1u == (tg + 1u) * nx) xb_add(&bar[XB_TOPGEN], 1u);
            else XB_SPIN(xb_ld(&bar[XB_TOPGEN]) == tg, bar);
            __builtin_amdgcn_fence(__ATOMIC_ACQUIRE, "agent");
            xb_add(&bar[XB_XGEN(b.x)], 1u);
            asm volatile("s_waitcnt vmcnt(0)" ::: "memory");
        } else {
            XB_SPIN(xb_ld(&bar[XB_XGEN(b.x)]) == gen, bar);
            __builtin_amdgcn_fence(__ATOMIC_ACQUIRE, "agent");
            asm volatile("s_waitcnt vmcnt(0)" ::: "memory");
        }
    }
    __syncthreads();
}

struct Args { const float* in[29]; float* out; unsigned char* ws; int ph_lo, ph_hi; };
enum { I_X = 0, I_C, I_CTX, I_CCTX, I_WMOD, I_BMOD, I_NPREMIX, I_NPOSTMIX, I_NPREFFN, I_NPOSTFFN, I_WIN, I_CONVW, I_CONVB, I_WA, I_BA, I_WX, I_BX, I_LAM,
       I_POOLW, I_POOLS, I_WRNN, I_WPOOL, I_WOUT, I_RW, I_RB, I_W1, I_B1, I_W2, I_B2 };

struct Frame { LAS unsigned char* lds; int tid, lane, wave, G, blk; };

struct TrDesc { const float* src; bf16* dst; int ldw, ldt, k0, n0, kind, p0, p1; };
__device__ __forceinline__ int tr_row(const TrDesc& d, int n) {
    if (d.kind == 0 || d.kind == 3) return d.p0 + n;
    if (d.kind == 1) { const int cg = n >> 6, cc = n & 63, g = d.p1; return (d.p0 * 4 + cg) * 256 + 128 * (g >> 1) + 32 * (cc >> 4) + 16 * (g & 1) + (cc & 15); }
    const int j = n & 1023; return d.p0 * 2048 + (j >> 7) * 256 + (n >> 10) * 128 + (j & 127);
}
__device__ __forceinline__ bool tr_decode(const Args& a, int it, TrDesc& d) {
    constexpr int I0 = 16 * 160, I1 = 16 * 32, I2 = 4 * 32, I3 = 512, I4 = 512, I5 = 512;
    unsigned char* ws = a.ws; int r = it; d.kind = 0; d.p0 = 0; d.p1 = 0;
    if (r < I0) { const int kb = r / 160, nb = r % 160; d.src = a.in[I_WIN]; d.ldw = INC; d.dst = (bf16*)(ws + WS_WIN); d.ldt = 1024; d.k0 = kb * 64; d.n0 = nb * 32; return true; } r -= I0;
    if (r < I1) { const int mat = r >> 5, q = r & 31, kb = q >> 3, nb = q & 7; const int dir = mat >> 3, type = (mat >> 2) & 1, h = mat & 3;
        d.src = (type ? a.in[I_WX] : a.in[I_WA]) + (size_t)(dir * 4 + h) * 65536; d.ldw = 256; d.dst = (bf16*)(ws + WS_WG); d.ldt = 256; d.k0 = kb * 64; d.n0 = nb * 32; d.kind = 1; d.p0 = h; d.p1 = dir * 2 + type; return true; } r -= I1;
    if (r < I2) { const int gq = r >> 5, q = r & 31, kb = q >> 3, nb = q & 7; d.src = a.in[I_POOLW] + (size_t)gq * 65536; d.ldw = 256; d.dst = (bf16*)(ws + WS_WP); d.ldt = 256; d.k0 = kb * 64; d.n0 = nb * 32; d.p0 = gq * 256; return true; } r -= I2;
    if (r < I3) { const int kb = r >> 5, nb = r & 31; d.src = a.in[I_WRNN]; d.ldw = 1024; d.dst = (bf16*)(ws + WS_WPROJ); d.ldt = 1024; d.k0 = kb * 64; d.n0 = nb * 32; return true; } r -= I3;
    if (r < I4) { const int kb = r >> 5, nb = r & 31; d.src = a.in[I_WPOOL]; d.ldw = 1024; d.dst = (bf16*)(ws + WS_WPROJ); d.ldt = 1024; d.k0 = kb * 64; d.n0 = nb * 32; d.p0 = 1024; return true; } r -= I4;
    if (r < I5) { const int kb = r >> 5, nb = r & 31; d.src = a.in[I_WOUT]; d.ldw = 1024; d.dst = (bf16*)(ws + WS_WOUT); d.ldt = 1024; d.k0 = kb * 64; d.n0 = nb * 32; return true; } r -= I5;
    return false;
}
__device__ __forceinline__ void tr_load(const TrDesc& d, f32x4 (&v)[8], int lane) {
    const float* p = d.src + (size_t)(d.k0 + (lane >> 3)) * d.ldw + d.n0 + (lane & 7) * 4;
#pragma unroll
    for (int i = 0; i < 8; ++i) v[i] = __builtin_nontemporal_load((const f32x4*)(p + (size_t)(8 * i) * d.ldw));
}
__device__ __forceinline__ void tr_store(const TrDesc& d, const f32x4 (&v)[8], LAS float* scr, int lane) {
    const int kr = lane >> 3, n4 = (lane & 7) * 4;
#pragma unroll
    for (int i = 0; i < 8; ++i) { LAS float* s = scr + (kr + 8 * i) * 33 + n4; s[0] = v[i].x; s[1] = v[i].y; s[2] = v[i].z; s[3] = v[i].w; }
    LDS_WAIT(); asm volatile("" ::: "memory");
    const int c = lane & 7;
#pragma unroll
    for (int j = 0; j < 4; ++j) { const int n = (lane >> 3) + 8 * j; const LAS float* s = scr + (8 * c) * 33 + n;
        u32x4 o; o.x = cvt_pk_bf16(s[0 * 33], s[1 * 33]); o.y = cvt_pk_bf16(s[2 * 33], s[3 * 33]); o.z = cvt_pk_bf16(s[4 * 33], s[5 * 33]); o.w = cvt_pk_bf16(s[6 * 33], s[7 * 33]);
        *(u32x4*)(d.dst + (size_t)tr_row(d, d.n0 + n) * d.ldt + d.k0 + 8 * c) = o; }
    LDS_WAIT(); asm volatile("" ::: "memory");
}

__device__ __forceinline__ void p0_expert_tiles(const Frame& F, const Args& a) {
    LAS float* scr = (LAS float*)F.lds;
    constexpr int T1 = 32 * 8 * 16, T2 = 32 * 8 * 8, NT = T1 + T2;
    const int r16 = F.tid >> 5, c4 = (F.tid & 31) * 4, tn_ = F.tid >> 2, kq = F.tid & 3;
    f32x4 v[8];
    auto src_of = [&](int t, int& ldw) -> const float* {
        if (t < T1) { const int e = t >> 7, q = t & 127, kb = q >> 4, nb = q & 15; ldw = 2048; return a.in[I_W1] + (size_t)e * 1024 * 2048 + (size_t)(kb * 128) * 2048 + nb * 128; }
        const int u = t - T1, e = u >> 6, q = u & 63, kb = q >> 3, nb = q & 7; ldw = 1024; return a.in[I_W2] + (size_t)e * 1024 * 1024 + (size_t)(kb * 128) * 1024 + nb * 128; };
    auto dst_of = [&](int t) -> unsigned char* {
        if (t < T1) { const int e = t >> 7, q = t & 127, kb = q >> 4, nb = q & 15; return a.ws + WS_W1T + ((size_t)e * 2048 + (nb & 7) * 256 + (nb >> 3) * 128) * 1024 + kb * 128; }
        const int u = t - T1, e = u >> 6, q = u & 63, kb = q >> 3, nb = q & 7; return a.ws + WS_W2T + ((size_t)e * 1024 + nb * 128) * 1024 + kb * 128; };
    unsigned* qhead = (unsigned*)(a.ws + WS_CTL) + CW_TILEQ; LAS int* qslot = (LAS int*)(F.lds + LDS_CNT);
    auto grab = [&]() -> int { if (F.tid == 0) qslot[0] = (int)__hip_atomic_fetch_add(qhead, 1u, __ATOMIC_RELAXED, __HIP_MEMORY_SCOPE_AGENT); __syncthreads(); const int r = qslot[0]; __syncthreads(); return r; };
    int t = grab(), tn = grab();
    if (t < NT) { int ldw; const float* s = src_of(t, ldw) + (size_t)r16 * ldw + c4;
#pragma unroll
        for (int i = 0; i < 8; ++i) v[i] = __builtin_nontemporal_load((const f32x4*)(s + (size_t)(16 * i) * ldw)); }
    while (t < NT) {
        int rq = 0; if (F.tid == 0) rq = (int)__hip_atomic_fetch_add(qhead, 1u, __ATOMIC_RELAXED, __HIP_MEMORY_SCOPE_AGENT);
#pragma unroll
        for (int i = 0; i < 8; ++i) { LAS float* p = scr + (r16 + 16 * i) * 129 + c4; p[0] = v[i].x; p[1] = v[i].y; p[2] = v[i].z; p[3] = v[i].w; }
        __syncthreads();
        if (tn < NT) { int ldw; const float* s = src_of(tn, ldw) + (size_t)r16 * ldw + c4;
#pragma unroll
            for (int i = 0; i < 8; ++i) v[i] = __builtin_nontemporal_load((const f32x4*)(s + (size_t)(16 * i) * ldw)); }
        unsigned o[8]; const LAS float* q = scr + (32 * kq) * 129 + tn_;
#pragma unroll
        for (int w = 0; w < 8; ++w) { int x = __builtin_amdgcn_cvt_pk_fp8_f32(q[(4 * w) * 129] * W8SCALE, q[(4 * w + 1) * 129] * W8SCALE, 0, false);
            x = __builtin_amdgcn_cvt_pk_fp8_f32(q[(4 * w + 2) * 129] * W8SCALE, q[(4 * w + 3) * 129] * W8SCALE, x, true); o[w] = (unsigned)x; }
        unsigned char* d = dst_of(t) + (size_t)tn_ * 1024 + 32 * kq;
        __builtin_nontemporal_store((u32x4){o[0], o[1], o[2], o[3]}, (u32x4*)d); __builtin_nontemporal_store((u32x4){o[4], o[5], o[6], o[7]}, (u32x4*)(d + 16));
        if (F.tid == 0) qslot[0] = rq;
        __syncthreads();
        t = tn; tn = qslot[0];
    }
}

__device__ __forceinline__ void p0_prologue(const Frame& F, const Args& a) {
    unsigned char* ws = a.ws;
    if (F.blk < 96) {
        LAS float* sil = (LAS float*)(F.lds);
        LAS float* red = (LAS float*)(F.lds + 16384);
        for (int i = F.tid; i < 3 * 1024; i += 512) { const int r = i >> 10, k = i & 1023; const float cv = (r < 2) ? a.in[I_C][r * 1024 + k] : a.in[I_CCTX][k]; sil[i] = cv * frcp(1.0f + fexp2(-LOG2E * cv)); }
        __syncthreads();
        const int col = F.blk * 64 + F.lane; const float* wm = a.in[I_WMOD] + col;
        float a0 = 0.f, a1 = 0.f, a2 = 0.f;
        const int kb = F.wave * 128;
#pragma unroll 32
        for (int k = 0; k < 128; ++k) { const float w = __builtin_nontemporal_load(wm + (size_t)(kb + k) * 6144); a0 += sil[kb + k] * w; a1 += sil[1024 + kb + k] * w; a2 += sil[2048 + kb + k] * w; }
        red[(F.wave * 3 + 0) * 64 + F.lane] = a0; red[(F.wave * 3 + 1) * 64 + F.lane] = a1; red[(F.wave * 3 + 2) * 64 + F.lane] = a2;
        __syncthreads();
        if (F.tid < 192) { const int r = F.tid >> 6, l = F.tid & 63; float s = a.in[I_BMOD][F.blk * 64 + l];
#pragma unroll
            for (int w = 0; w < 8; ++w) s += red[(w * 3 + r) * 64 + l];
            ((float*)(ws + WS_MOD))[r * 6144 + F.blk * 64 + l] = s; }
        VM_WAIT();
        __syncthreads();
        if (F.blk < 32 && F.tid == 0) {
            __builtin_amdgcn_fence(__ATOMIC_RELEASE, "agent"); VM_WAIT();
            __hip_atomic_fetch_add((unsigned*)(ws + WS_CTL) + CW_MODFLAG, 1u, __ATOMIC_RELAXED, __HIP_MEMORY_SCOPE_AGENT); }
    }
    const int gtid = F.blk * 512 + F.tid, NGT = F.G * 512;
    for (int i = gtid; i < 2048; i += NGT) { const float lam = a.in[I_LAM][i]; ((float*)(ws + WS_SP2))[i] = 8.0f * LOG2E * log1pf(expf(-lam)); }
    LAS float* scr = (LAS float*)(F.lds + 32768 + F.wave * 8704);
    const int gw = F.blk * 8 + F.wave, NGW = F.G * 8;
    constexpr int NITEMS = 16 * 160 + 16 * 32 + 4 * 32 + 512 * 3;
    {
        TrDesc d0, d1, e0, e1; f32x4 v0[8], v1[8], w0[8], w1[8];
        int it = gw; bool h0 = tr_decode(a, it, d0), h1 = tr_decode(a, it + NGW, d1);
        if (h0) tr_load(d0, v0, F.lane); if (h1) tr_load(d1, v1, F.lane);
        while (h0) {
            const int itn = it + 2 * NGW; const bool g0 = tr_decode(a, itn, e0), g1 = tr_decode(a, itn + NGW, e1);
            if (g0) tr_load(e0, w0, F.lane); if (g1) tr_load(e1, w1, F.lane);
            tr_store(d0, v0, scr, F.lane); if (h1) tr_store(d1, v1, scr, F.lane);
            if (!g0) break;
            const int itm = itn + 2 * NGW; h0 = tr_decode(a, itm, d0); h1 = tr_decode(a, itm + NGW, d1);
            if (h0) tr_load(d0, v0, F.lane); if (h1) tr_load(d1, v1, F.lane);
            tr_store(e0, w0, scr, F.lane); if (g1) tr_store(e1, w1, scr, F.lane);
            it = itm;
        }
    }
    __syncthreads();
    p0_expert_tiles(F, a);
}

__device__ __forceinline__ void p1_prenorm(const Frame& F, const Args& a) {
    const float* mod = (const float*)(a.ws + WS_MOD); bf16* U = (bf16*)(a.ws + WS_U);
    if (F.tid == 0) {
        unsigned* flag = (unsigned*)(a.ws + WS_CTL) + CW_MODFLAG; unsigned sp = 0;
        while (__hip_atomic_load(flag, __ATOMIC_RELAXED, __HIP_MEMORY_SCOPE_AGENT) < 32u) { __builtin_amdgcn_s_sleep(4); if (++sp > (1u << 22)) break; }
        __builtin_amdgcn_fence(__ATOMIC_ACQUIRE, "agent"); VM_WAIT(); }
    __syncthreads();
    const int gw = F.blk * 8 + F.wave, NGW = F.G * 8;
    f32x4 Av[4], Bv[4], v[4], vn[4]; int curset = -1;
    if (gw < MT) { const float* src = gw < ML ? a.in[I_X] + (size_t)gw * D : a.in[I_CTX] + (size_t)(gw - ML) * D;
#pragma unroll
        for (int j = 0; j < 4; ++j) v[j] = __builtin_nontemporal_load((const f32x4*)(src + 4 * F.lane + 256 * j)); }
    for (int r = gw; r < MT; r += NGW) {
        const int rn = r + NGW;
        if (rn < MT) { const float* src = rn < ML ? a.in[I_X] + (size_t)rn * D : a.in[I_CTX] + (size_t)(rn - ML) * D;
#pragma unroll
            for (int j = 0; j < 4; ++j) vn[j] = __builtin_nontemporal_load((const f32x4*)(src + 4 * F.lane + 256 * j)); }
        const int set = r < SEQ ? 0 : (r < ML ? 1 : 2);
        if (set != curset) { curset = set;
#pragma unroll
            for (int j = 0; j < 4; ++j) { const int k = 4 * F.lane + 256 * j; const f32x4 gn = *(const f32x4*)(a.in[I_NPREMIX] + k), sc = *(const f32x4*)(mod + set * 6144 + 1024 + k); Av[j] = gn * (sc + 1.0f); Bv[j] = *(const f32x4*)(mod + set * 6144 + k); } }
        float ss = 0.f;
#pragma unroll
        for (int j = 0; j < 4; ++j) ss += (v[j].x * v[j].x + v[j].y * v[j].y) + (v[j].z * v[j].z + v[j].w * v[j].w);
        const float rs = __builtin_amdgcn_rsqf(wave_sum(ss) * (1.0f / D) + EPS);
#pragma unroll
        for (int j = 0; j < 4; ++j) { const f32x4 o = v[j] * rs * Av[j] + Bv[j]; u32x2 w; w.x = cvt_pk_bf16(o.x, o.y); w.y = cvt_pk_bf16(o.z, o.w); *(u32x2*)(U + (size_t)r * D + 4 * F.lane + 256 * j) = w; }
#pragma unroll
        for (int j = 0; j < 4; ++j) v[j] = vn[j];
    }
}

__device__ __forceinline__ void p3_conv_pool(const Frame& F, const Args& a) {
    const bf16* PROJ = (const bf16*)(a.ws + WS_PROJ); bf16* XC = (bf16*)(a.ws + WS_XC); bf16* DP = (bf16*)(a.ws + WS_DP);
    const int gtid = F.blk * 512 + F.tid, NGT = F.G * 512;
    for (int it = gtid; it < MT * 128; it += NGT) {
        const int r = it >> 7, c0 = (it & 127) * 8;
        int sb, t, len; if (r < ML) { sb = r & ~(SEQ - 1); t = r & (SEQ - 1); len = SEQ; } else { const int rr = r - ML; sb = ML + (rr & ~(CTXL - 1)); t = rr & (CTXL - 1); len = CTXL; }
        u32x4 cx[4]; float cm[4];
#pragma unroll
        for (int j = 0; j < 4; ++j) { const int tt = t - 2 + j; const bool ok = tt >= 0 && tt < len; cm[j] = ok ? 1.0f : 0.0f; cx[j] = *(const u32x4*)(PROJ + (size_t)(sb + (ok ? tt : t)) * INC + c0); }
        const bool lat = r < ML; const int rl = lat ? r : 0;
        const int pos = rl & 63, rb = rl - pos, h = 1 << (c0 >> 8); const int lo = pos - h < 0 ? 0 : pos - h, hi = pos + h > 64 ? 64 : pos + h;
        u32x4 px[16]; float pm[16];
        if (lat) {
#pragma unroll
            for (int q = 0; q < 16; ++q) { const int p = lo + q; const bool ok = p < hi; pm[q] = ok ? 1.0f : 0.0f; px[q] = *(const u32x4*)(PROJ + (size_t)(rb + (ok ? p : pos)) * INC + 2048 + c0); } }
        float acc[8];
        { const f32x4 b0 = *(const f32x4*)(a.in[I_CONVB] + c0), b1 = *(const f32x4*)(a.in[I_CONVB] + c0 + 4); acc[0] = b0.x; acc[1] = b0.y; acc[2] = b0.z; acc[3] = b0.w; acc[4] = b1.x; acc[5] = b1.y; acc[6] = b1.z; acc[7] = b1.w; }
#pragma unroll
        for (int j = 0; j < 4; ++j) { const u32x4 xv = cx[j]; const f32x4 w0 = *(const f32x4*)(a.in[I_CONVW] + j * 1024 + c0) * cm[j], w1 = *(const f32x4*)(a.in[I_CONVW] + j * 1024 + c0 + 4) * cm[j];
            acc[0] += w0.x * blo(xv.x); acc[1] += w0.y * bhi(xv.x); acc[2] += w0.z * blo(xv.y); acc[3] += w0.w * bhi(xv.y); acc[4] += w1.x * blo(xv.z); acc[5] += w1.y * bhi(xv.z); acc[6] += w1.z * blo(xv.w); acc[7] += w1.w * bhi(xv.w); }
        { u32x4 o; o.x = cvt_pk_bf16(acc[0], acc[1]); o.y = cvt_pk_bf16(acc[2], acc[3]); o.z = cvt_pk_bf16(acc[4], acc[5]); o.w = cvt_pk_bf16(acc[6], acc[7]); *(u32x4*)(XC + (size_t)r * D + c0) = o; }
        if (lat) {
            float s[8];
#pragma unroll
            for (int i = 0; i < 8; ++i) s[i] = 0.f;
#pragma unroll
            for (int q = 0; q < 16; ++q) { const u32x4 xv = px[q]; const float m = pm[q];
                s[0] += m * blo(xv.x); s[1] += m * bhi(xv.x); s[2] += m * blo(xv.y); s[3] += m * bhi(xv.y); s[4] += m * blo(xv.z); s[5] += m * bhi(xv.z); s[6] += m * blo(xv.w); s[7] += m * bhi(xv.w); }
            const float inv = 1.0f / (float)(hi - lo); const u32x4 xs = *(const u32x4*)(PROJ + (size_t)r * INC + 2048 + c0);
            u32x4 o; o.x = cvt_pk_bf16(s[0] * inv - blo(xs.x), s[1] * inv - bhi(xs.x)); o.y = cvt_pk_bf16(s[2] * inv - blo(xs.y), s[3] * inv - bhi(xs.y));
            o.z = cvt_pk_bf16(s[4] * inv - blo(xs.z), s[5] * inv - bhi(xs.z)); o.w = cvt_pk_bf16(s[6] * inv - blo(xs.w), s[7] * inv - bhi(xs.w));
            *(u32x4*)(DP + (size_t)r * D + c0) = o;
        }
    }
}

__device__ __forceinline__ void p6_carry(const Frame& F, const Args& a) {
    const float* AGG = (const float*)(a.ws + WS_AGG); float* CARRY = (float*)(a.ws + WS_CARRY);
    if (F.wave != 0) return;
    for (int w = F.blk; w < 256; w += F.G) {
        const int chain = w * 16 + (F.lane >> 2), seg = F.lane & 3, ch = chain & 1023, dir = (chain >> 10) & 1, b = chain >> 11;
        float A[33], E[33];
#pragma unroll
        for (int u = 0; u < 33; ++u) { const int k = 33 * seg + u; const int s = k < 4 ? NSUB_L + b * 4 + (dir ? 3 - k : k) : b * 128 + (dir ? 127 - (k - 4) : (k - 4));
            A[u] = AGG[((size_t)(s * 2 + dir) * 2) * D + ch]; E[u] = AGG[((size_t)(s * 2 + dir) * 2 + 1) * D + ch]; }
        float As = 0.f, hs = 0.f;
#pragma unroll
        for (int u = 0; u < 33; ++u) { As += A[u]; hs = fexp2(A[u]) * hs + E[u]; }
        float hin = 0.f;
#pragma unroll
        for (int j = 0; j < 3; ++j) { const float Aj = __shfl(As, (F.lane & ~3) + j), hj = __shfl(hs, (F.lane & ~3) + j); if (j < seg) hin = fexp2(Aj) * hin + hj; }
        float h = hin;
#pragma unroll
        for (int u = 0; u < 33; ++u) { const int k = 33 * seg + u;
            if (k >= 4) { const int s = b * 128 + (dir ? 127 - (k - 4) : (k - 4)); CARRY[(size_t)(s * 2 + dir) * D + ch] = h; }
            h = fexp2(A[u]) * h + E[u]; }
    }
}

__device__ __forceinline__ void p7_scan_out(const Frame& F, const Args& a) {
    const float* CARRY = (const float*)(a.ws + WS_CARRY);
    const int gw = F.blk * 8 + F.wave, NGW = F.G * 8;
    for (int it = gw; it < NSUB_L * 8; it += NGW) {
        const int sub = it >> 3, c0 = (it & 7) * 128 + F.lane * 2, r0 = sub * 64;
        unsigned hf[64];
        { const unsigned* la = (const unsigned*)((const bf16*)(a.ws + WS_LAF) + (size_t)r0 * D + c0); const unsigned* bb = (const unsigned*)((const bf16*)(a.ws + WS_BF) + (size_t)r0 * D + c0);
          const f32x2 cf = *(const f32x2*)(CARRY + (size_t)(sub * 2 + 0) * D + c0); float h0 = cf.x, h1 = cf.y;
          unsigned lv[16], bv[16], ln[16], bn[16];
#pragma unroll
          for (int u = 0; u < 16; ++u) { lv[u] = la[(size_t)u * (D / 2)]; bv[u] = bb[(size_t)u * (D / 2)]; }
#pragma unroll
          for (int tb = 0; tb < 4; ++tb) { const int t0 = tb * 16;
              if (tb < 3) {
#pragma unroll
                  for (int u = 0; u < 16; ++u) { ln[u] = la[(size_t)(t0 + 16 + u) * (D / 2)]; bn[u] = bb[(size_t)(t0 + 16 + u) * (D / 2)]; } }
#pragma unroll
              for (int u = 0; u < 16; ++u) { h0 = fexp2(blo(lv[u])) * h0 + blo(bv[u]); h1 = fexp2(bhi(lv[u])) * h1 + bhi(bv[u]); hf[t0 + u] = cvt_pk_bf16(h0, h1); }
#pragma unroll
              for (int u = 0; u < 16; ++u) { lv[u] = ln[u]; bv[u] = bn[u]; } } }
        { const unsigned* la = (const unsigned*)((const bf16*)(a.ws + WS_LAB) + (size_t)r0 * D + c0); const unsigned* bb = (const unsigned*)((const bf16*)(a.ws + WS_BB) + (size_t)r0 * D + c0);
          const unsigned* gp = (const unsigned*)((const bf16*)(a.ws + WS_PROJ) + (size_t)r0 * INC + 1024 + c0);
          unsigned* y = (unsigned*)((bf16*)(a.ws + WS_YY) + (size_t)r0 * D + c0);
          const f32x2 cb = *(const f32x2*)(CARRY + (size_t)(sub * 2 + 1) * D + c0); float h0 = cb.x, h1 = cb.y;
          unsigned lv[16], bv[16], gv[16], ln[16], bn[16], gn[16];
#pragma unroll
          for (int u = 0; u < 16; ++u) { const int t = 63 - u; lv[u] = la[(size_t)t * (D / 2)]; bv[u] = bb[(size_t)t * (D / 2)]; gv[u] = gp[(size_t)t * (INC / 2)]; }
#pragma unroll
          for (int sb = 0; sb < 4; ++sb) { const int s0 = sb * 16;
              if (sb < 3) {
#pragma unroll
                  for (int u = 0; u < 16; ++u) { const int t = 63 - (s0 + 16 + u); ln[u] = la[(size_t)t * (D / 2)]; bn[u] = bb[(size_t)t * (D / 2)]; gn[u] = gp[(size_t)t * (INC / 2)]; } }
#pragma unroll
              for (int u = 0; u < 16; ++u) { const int t = 63 - (s0 + u); h0 = fexp2(blo(lv[u])) * h0 + blo(bv[u]); h1 = fexp2(bhi(lv[u])) * h1 + bhi(bv[u]);
                  y[(size_t)t * (D / 2)] = cvt_pk_bf16((blo(hf[t]) + h0) * blo(gv[u]), (bhi(hf[t]) + h1) * bhi(gv[u])); }
#pragma unroll
              for (int u = 0; u < 16; ++u) { lv[u] = ln[u]; bv[u] = bn[u]; gv[u] = gn[u]; } } }
    }
}

__device__ __forceinline__ void p10_post_mix_route(const Frame& F, const Args& a, int bank = 0) {
    const float* mod = (const float*)(a.ws + WS_MOD); const bf16* MLAT = (const bf16*)(a.ws + WS_MLAT); unsigned char* VB = (unsigned char*)(a.ws + WS_VB); bf16* X1 = (bf16*)(a.ws + WS_X1);
    int* pair_e = (int*)(a.ws + WS_PAIR_E); float* pair_w = (float*)(a.ws + WS_PAIR_W); int* pair_pos = (int*)(a.ws + WS_PAIR_POS);
    unsigned* gcnt = (unsigned*)(a.ws + WS_CTL) + CW_GCNT + bank * 2048;
    LAS float* vt = (LAS float*)F.lds;
    LAS float* red = (LAS float*)F.lds;
    LAS float* lgt = (LAS float*)(F.lds + LDS_LGT);
    LAS int* lcnt = (LAS int*)(F.lds + LDS_CNT); LAS int* lbase = lcnt + 32; LAS int* rec_e = lcnt + 64; LAS int* rec_lp = lcnt + 64 + 256;
    float wreg[64];
#pragma unroll
    for (int s = 0; s < 64; ++s) wreg[s] = a.in[I_RW][(size_t)(128 * F.wave + 2 * s + (F.lane >> 5)) * 32 + (F.lane & 31)];
    if (F.tid < 32) lcnt[F.tid] = 0;
    __syncthreads();
    for (int r0 = F.blk * 64; r0 < ML; r0 += F.G * 64) {
        const int b = r0 >> 13; const float* mb = mod + b * 6144;
        f32x4 Gm[4], Av[4], Bv[4];
        { f32x4 t0[4], t1[4], t2[4], t3[4];
#pragma unroll
          for (int j = 0; j < 4; ++j) { const int k = 4 * F.lane + 256 * j; t0[j] = *(const f32x4*)(mb + 2048 + k); t1[j] = *(const f32x4*)(a.in[I_NPOSTMIX] + k); t2[j] = *(const f32x4*)(a.in[I_NPREFFN] + k); t3[j] = *(const f32x4*)(mb + 4096 + k); Bv[j] = *(const f32x4*)(mb + 3072 + k); }
#pragma unroll
          for (int j = 0; j < 4; ++j) { Gm[j] = t0[j] * t1[j]; Av[j] = t2[j] * (t3[j] + 1.0f); } }
        for (int pass = 0; pass < 2; ++pass) {
            const int rw0 = r0 + pass * 32 + F.wave * 4;
            u32x2 mln[4]; f32x4 xn[4];
#pragma unroll
            for (int j = 0; j < 4; ++j) { const size_t o = (size_t)rw0 * D + 4 * F.lane + 256 * j; mln[j] = *(const u32x2*)(MLAT + o); xn[j] = *(const f32x4*)(a.in[I_X] + o); }
            for (int i = 0; i < 4; ++i) {
                const int r = rw0 + i, t = F.wave * 4 + i;
                f32x4 v[4], x1[4]; float ss = 0.f;
#pragma unroll
                for (int j = 0; j < 4; ++j) { v[j] = (f32x4){blo(mln[j].x), bhi(mln[j].x), blo(mln[j].y), bhi(mln[j].y)}; x1[j] = xn[j]; ss += (v[j].x * v[j].x + v[j].y * v[j].y) + (v[j].z * v[j].z + v[j].w * v[j].w); }
                if (i < 3) {
#pragma unroll
                    for (int j = 0; j < 4; ++j) { const size_t o = (size_t)(r + 1) * D + 4 * F.lane + 256 * j; mln[j] = *(const u32x2*)(MLAT + o); xn[j] = *(const f32x4*)(a.in[I_X] + o); } }
                const float rs1 = __builtin_amdgcn_rsqf(wave_sum(ss) * (1.0f / D) + EPS);
                float ss2 = 0.f;
#pragma unroll
                for (int j = 0; j < 4; ++j) { x1[j] = x1[j] + Gm[j] * (v[j] * rs1); ss2 += (x1[j].x * x1[j].x + x1[j].y * x1[j].y) + (x1[j].z * x1[j].z + x1[j].w * x1[j].w); }
                const float rs2 = __builtin_amdgcn_rsqf(wave_sum(ss2) * (1.0f / D) + EPS);
#pragma unroll
                for (int j = 0; j < 4; ++j) { const int k = 4 * F.lane + 256 * j; v[j] = x1[j] * rs2 * Av[j] + Bv[j];
                    LAS float* vp = vt + t * 1025 + k; vp[0] = v[j].x; vp[1] = v[j].y; vp[2] = v[j].z; vp[3] = v[j].w; }
#pragma unroll
                for (int j = 0; j < 4; ++j) { const int k = 4 * F.lane + 256 * j; { u32x2 xw; xw.x = cvt_pk_bf16(x1[j].x, x1[j].y); xw.y = cvt_pk_bf16(x1[j].z, x1[j].w); *(u32x2*)(X1 + (size_t)r * D + k) = xw; }
                    int w = __builtin_amdgcn_cvt_pk_fp8_f32(v[j].x, v[j].y, 0, false); w = __builtin_amdgcn_cvt_pk_fp8_f32(v[j].z, v[j].w, w, true); *(int*)(VB + (size_t)r * D + k) = w; }
            }
            __syncthreads();
            f32x16 acc;
#pragma unroll
            for (int q = 0; q < 16; ++q) acc[q] = 0.f;
            { const LAS float* ap = vt + (F.lane & 31) * 1025 + 128 * F.wave + (F.lane >> 5);
#pragma unroll
              for (int s = 0; s < 64; ++s) acc = __builtin_amdgcn_mfma_f32_32x32x2f32(ap[2 * s], wreg[s], acc, 0, 0, 0); }
            __syncthreads();
#pragma unroll
            for (int q = 0; q < 16; ++q) { const int tok = (q & 3) + 8 * (q >> 2) + 4 * (F.lane >> 5); red[(F.wave * 32 + tok) * 32 + (F.lane & 31)] = acc[q]; }
            __syncthreads();
#pragma unroll
            for (int q = 0; q < 2; ++q) { const int idx = F.tid + 512 * q, t = idx >> 5, e = idx & 31; float s = a.in[I_RB][e];
#pragma unroll
                for (int w = 0; w < 8; ++w) s += red[(w * 32 + t) * 32 + e];
                lgt[t * 33 + e] = s; }
            __syncthreads();
            if (F.tid < 32) {
                const int t = F.tid, ts = pass * 32 + t, r = r0 + ts;
                float lg[32];
#pragma unroll
                for (int e = 0; e < 32; ++e) lg[e] = lgt[t * 33 + e];
                float tv[4]; int ti[4];
#pragma unroll
                for (int k = 0; k < 4; ++k) { float best = -3.0e38f; int bi = 0;
#pragma unroll
                    for (int e = 0; e < 32; ++e) { if (lg[e] > best) { best = lg[e]; bi = e; } }
                    tv[k] = best; ti[k] = bi;
#pragma unroll
                    for (int e = 0; e < 32; ++e) lg[e] = (e == bi) ? -3.0e38f : lg[e]; }
                const float e1 = fexp2((tv[1] - tv[0]) * LOG2E), e2 = fexp2((tv[2] - tv[0]) * LOG2E), e3 = fexp2((tv[3] - tv[0]) * LOG2E), inv = 1.0f / (1.0f + e1 + e2 + e3);
                const float wk[4] = {inv, e1 * inv, e2 * inv, e3 * inv};
#pragma unroll
                for (int k = 0; k < 4; ++k) { const int e = ti[k]; const int lp = __hip_atomic_fetch_add(lcnt + e, 1, __ATOMIC_RELAXED, __HIP_MEMORY_SCOPE_WORKGROUP);
                    rec_e[ts * 4 + k] = e; rec_lp[ts * 4 + k] = lp; }
                *(int4*)(pair_e + r * 4) = make_int4(ti[0], ti[1], ti[2], ti[3]); *(f32x4*)(pair_w + r * 4) = (f32x4){wk[0], wk[1], wk[2], wk[3]};
            }
        }
        __syncthreads();
        if (F.tid < 32) { const int n = lcnt[F.tid]; lbase[F.tid] = (int)__hip_atomic_fetch_add(gcnt + 64 * F.tid, (unsigned)n, __ATOMIC_RELAXED, __HIP_MEMORY_SCOPE_AGENT); lcnt[F.tid] = 0; }
        __syncthreads();
        if (F.tid < 256) { const int e = rec_e[F.tid], pos = lbase[e] + rec_lp[F.tid]; pair_pos[r0 * 4 + F.tid] = pos; ((int*)(a.ws + WS_TOKL))[e * ML + pos] = r0 + (F.tid >> 2); }
        __syncthreads();
    }
}

__device__ __forceinline__ void build_tile_table(const Frame& F, const Args& a) {
    LAS int* tab = (LAS int*)(F.lds + LDS_TAB); LAS int* off = (LAS int*)(F.lds + LDS_CNT) + 640;
    const unsigned* gcnt = (const unsigned*)(a.ws + WS_CTL) + CW_GCNT;
    __syncthreads();
    if (F.tid < 64) {
        const int e = F.lane & 31; const int c = (int)__hip_atomic_load(gcnt + 64 * e, __ATOMIC_RELAXED, __HIP_MEMORY_SCOPE_AGENT); const int n = (c + 255) >> 8;
        int incl = n;
#pragma unroll
        for (int d = 1; d < 32; d <<= 1) { const int t = __shfl_up(incl, d, 32); if (e >= d) incl += t; }
        const int base = incl - n;
        if (F.lane < 32) { off[e] = base * 256; tab[340 + e] = c; for (int i = 0; i < n && base + i < MAXTILES; ++i) tab[base + i] = e | (i << 8);
            if (e == 31) { off[32] = incl * 256; tab[300] = incl < MAXTILES ? incl : MAXTILES; } }
    }
    __syncthreads();
}

__device__ __forceinline__ void p14_final(const Frame& F, const Args& a) {
    const float* mod = (const float*)(a.ws + WS_MOD); const unsigned char* OE = (const unsigned char*)(a.ws + WS_APERM); const bf16* X1 = (const bf16*)(a.ws + WS_X1);
    const int* pair_e = (const int*)(a.ws + WS_PAIR_E); const int* pair_pos = (const int*)(a.ws + WS_PAIR_POS); const float* pair_w = (const float*)(a.ws + WS_PAIR_W);
    const LAS int* off = (const LAS int*)(F.lds + LDS_CNT) + 640;
    const int gw = F.blk * 8 + F.wave, NGW = F.G * 8;
    const int nmine = (ML - gw + NGW - 1) / NGW;
    f32x4 Gm[4]; int curb = -1;
    for (int ib = 0; ib < nmine; ib += 8) {
        int myslot = 0; float myw = 0.f;
        if (F.lane < 32 && ib + (F.lane >> 2) < nmine) { const int r = gw + NGW * (ib + (F.lane >> 2)); myslot = off[pair_e[r * 4 + (F.lane & 3)]] + pair_pos[r * 4 + (F.lane & 3)]; myw = pair_w[r * 4 + (F.lane & 3)] * O8INV; }
        u32x4 ov[4], on[4]; u32x4 x1[2], xn[2];
        { const int r = gw + NGW * ib;
#pragma unroll
          for (int k = 0; k < 4; ++k) { const int slot = __builtin_amdgcn_readlane(myslot, k); ov[k] = *(const u32x4*)(OE + (size_t)slot * D + F.lane * 16); }
#pragma unroll
          for (int j = 0; j < 2; ++j) x1[j] = *(const u32x4*)(X1 + (size_t)r * D + F.lane * 16 + j * 8); }
        for (int i = 0; i < 8 && ib + i < nmine; ++i) {
            const int r = gw + NGW * (ib + i), b = r >> 13;
            if (i + 1 < 8 && ib + i + 1 < nmine) { const int rn = r + NGW;
#pragma unroll
                for (int k = 0; k < 4; ++k) { const int slot = __builtin_amdgcn_readlane(myslot, (i + 1) * 4 + k); on[k] = *(const u32x4*)(OE + (size_t)slot * D + F.lane * 16); }
#pragma unroll
                for (int j = 0; j < 2; ++j) xn[j] = *(const u32x4*)(X1 + (size_t)rn * D + F.lane * 16 + j * 8); }
            if (b != curb) { curb = b;
#pragma unroll
                for (int j = 0; j < 4; ++j) { const int k = F.lane * 16 + j * 4; Gm[j] = *(const f32x4*)(mod + b * 6144 + 5120 + k) * *(const f32x4*)(a.in[I_NPOSTFFN] + k); } }
            float f[16];
#pragma unroll
            for (int q = 0; q < 16; ++q) f[q] = 0.f;
#pragma unroll
            for (int k = 0; k < 4; ++k) { const float w = __builtin_bit_cast(float, __builtin_amdgcn_readlane(__builtin_bit_cast(int, myw), i * 4 + k)); const u32x4 v = ov[k];
                const unsigned vw[4] = {v.x, v.y, v.z, v.w};
#pragma unroll
                for (int q = 0; q < 4; ++q) { const f32x2 lo = __builtin_amdgcn_cvt_pk_f32_fp8((int)vw[q], false), hi = __builtin_amdgcn_cvt_pk_f32_fp8((int)vw[q], true);
                    f[q * 4 + 0] += w * lo.x; f[q * 4 + 1] += w * lo.y; f[q * 4 + 2] += w * hi.x; f[q * 4 + 3] += w * hi.y; } }
            float ss = 0.f;
#pragma unroll
            for (int q = 0; q < 16; ++q) ss += f[q] * f[q];
            const float rs = __builtin_amdgcn_rsqf(wave_sum(ss) * (1.0f / D) + EPS);
#pragma unroll
            for (int j = 0; j < 4; ++j) { const int k = F.lane * 16 + j * 4; const u32x4 xw = x1[j >> 1];
                const f32x4 fv = (f32x4){f[j * 4 + 0], f[j * 4 + 1], f[j * 4 + 2], f[j * 4 + 3]};
                const f32x4 xv = (j & 1) ? (f32x4){blo(xw.z), bhi(xw.z), blo(xw.w), bhi(xw.w)} : (f32x4){blo(xw.x), bhi(xw.x), blo(xw.y), bhi(xw.y)};
                *(f32x4*)(a.out + (size_t)r * D + k) = xv + Gm[j] * (fv * rs); }
#pragma unroll
            for (int k = 0; k < 4; ++k) ov[k] = on[k];
#pragma unroll
            for (int j = 0; j < 2; ++j) x1[j] = xn[j];
        }
    }
}

__device__ __forceinline__ void ctx_proj_mini(const Frame& F, const Args& a) {
    const bf16* U = (const bf16*)(a.ws + WS_U); const bf16* W = (const bf16*)(a.ws + WS_WIN); bf16* PROJ = (bf16*)(a.ws + WS_PROJ);
    LAS float* part = (LAS float*)F.lds + F.wave * 1024;
    for (int gw0 = 0; gw0 < 2048; gw0 += F.G * 8) {
    const int gw = gw0 + F.blk * 8 + F.wave; const bool act = gw < 2048;
    const int tile = gw >> 2, kq = gw & 3, row0 = ML + 32 * (tile >> 5), col0 = 32 * (tile & 31), lr = F.lane & 31, lh = F.lane >> 5;
    if (act) {
        const bf16* ap = U + (size_t)(row0 + lr) * D + 256 * kq + 8 * lh; const bf16* bp = W + (size_t)(col0 + lr) * D + 256 * kq + 8 * lh;
        f32x16 acc;
#pragma unroll
        for (int q = 0; q < 16; ++q) acc[q] = 0.f;
        bf16x8 av[16], bv[16];
#pragma unroll
        for (int s = 0; s < 16; ++s) { av[s] = *(const bf16x8*)(ap + 16 * s); bv[s] = *(const bf16x8*)(bp + 16 * s); }
#pragma unroll
        for (int s = 0; s < 16; ++s) acc = __builtin_amdgcn_mfma_f32_32x32x16_bf16(av[s], bv[s], acc, 0, 0, 0);
#pragma unroll
        for (int q = 0; q < 16; ++q) part[q * 64 + F.lane] = acc[q]; }
    __syncthreads();
    if (act && kq == 0) {
#pragma unroll
        for (int q = 0; q < 16; q += 2) { float s0 = 0.f, s1 = 0.f;
#pragma unroll
            for (int w = 0; w < 4; ++w) { s0 += part[w * 1024 + q * 64 + F.lane]; s1 += part[w * 1024 + (q + 1) * 64 + F.lane]; }
            const int r0 = (q & 3) + 8 * (q >> 2) + 4 * lh; const unsigned w_ = cvt_pk_bf16(s0, s1); const unsigned wn = (unsigned)__shfl_xor((int)w_, 1);
            const unsigned o = (lr & 1) ? ((wn >> 16) | (w_ & 0xffff0000u)) : ((w_ & 0xffffu) | (wn << 16));
            *(unsigned*)(PROJ + (size_t)(row0 + r0 + (lr & 1)) * INC + col0 + (lr & ~1)) = o; } }
    __syncthreads();
    }
}

using pg8::Unit;
struct OrdProj {
    int G, c;
    __device__ __forceinline__ bool next(int i, Unit& u) const { const int L = i * G + c; if (L >= 1280) return false;
        int pm, pn; pg8::tile_order(L, 64, 20, pm, pn);
        u.pm = pm; u.pn = pn; u.aux = 0; u.aoff = (size_t)pm * 256 * D * 2; u.boff = (size_t)pn * 256 * D * 2; return true; }
};
struct OrdGates {
    int G, c;
    __device__ __forceinline__ bool next(int i, Unit& u) const { const int L = i * G + c; if (L >= 66 * 16) return false;
        int pm, pn; pg8::tile_order(L, 66, 16, pm, pn);
        u.pm = pm; u.pn = pn; u.aux = 0; u.aoff = ((size_t)pm * 256 * D + (pn >> 2) * 256) * 2; u.boff = (size_t)pn * 256 * 256 * 2; return true; }
};
struct OrdPool {
    int G, c;
    __device__ __forceinline__ bool next(int i, Unit& u) const {
        int L; if (G == 256) { if (c < 32) return false; L = i * 224 + (c - 32); } else L = i * G + c;
        if (L >= 256) return false;
        int pm, pn; pg8::tile_order(L, 64, 4, pm, pn);
        u.pm = pm; u.pn = pn; u.aux = 0; u.aoff = ((size_t)pm * 256 * D + pn * 256) * 2; u.boff = (size_t)pn * 256 * 256 * 2; return true; }
};
struct OrdBranch {
    int G, c;
    __device__ __forceinline__ bool next(int i, Unit& u) const { const int L = (i >> 1) * G + c, which = i & 1; if (L >= 256) return false;
        int pm, pn; pg8::tile_order(L, 64, 4, pm, pn);
        u.pm = pm; u.pn = pn; u.aux = which; u.aoff = ((size_t)which * ML + (size_t)pm * 256) * D * 2; u.boff = ((size_t)which * 1024 + (size_t)pn * 256) * D * 2; return true; }
};
struct OrdOut {
    int G, c;
    __device__ __forceinline__ bool next(int i, Unit& u) const { const int L = i * G + c; if (L >= 256) return false;
        int pm, pn; pg8::tile_order(L, 64, 4, pm, pn);
        u.pm = pm; u.pn = pn; u.aux = 0; u.aoff = (size_t)pm * 256 * D * 2; u.boff = (size_t)pn * 256 * D * 2; return true; }
};
template <int NT, bool GATHER> struct OrdMoe {
    int G, c; const LAS int* tab; int ntm;
    __device__ __forceinline__ bool next(int i, Unit& u) const {
        const int cv = (G % 8 == 0) ? (c & 7) * (G >> 3) + (c >> 3) : c; const int L = i * G + cv; if (L >= ntm * NT) return false;
        const int mt = L / NT, nt = L % NT; const int te = __builtin_amdgcn_readfirstlane(tab[mt]); const int e = te & 255, j = te >> 8;
        u.pm = mt; u.pn = nt; u.aux = e; u.boff = ((size_t)e * NT + nt) * 256 * D;
        if (GATHER) { const int cnt = __builtin_amdgcn_readfirstlane(tab[340 + e]); int nv = cnt - j * 256; nv = nv > 256 ? 256 : nv; u.aoff = ((size_t)(unsigned)nv << 32) | (unsigned)(e * ML + j * 256); }
        else u.aoff = (size_t)mt * 256 * D;
        return true; }
};

using pg8::HALF;
struct EpiProj {
    static constexpr bool PERM = true; bf16* O;
    __device__ __forceinline__ void operator()(const f32x4 (&acc)[2][2][4][2], const Unit& u, int wr, int wc, int fr, int fq) const {
        const int row0 = u.pm * 256 + wr * 64 + fr, col0 = u.pn * 256 + wc * 32 + 8 * fq; const int act = (u.pn >= 4 && u.pn < 8) ? 1 : (u.pn >= 12 ? 2 : 0);
#pragma unroll
        for (int ai = 0; ai < 2; ++ai)
#pragma unroll
            for (int m = 0; m < 4; ++m) { bf16* rowp = O + (size_t)(row0 + ai * HALF + m * 16) * INC + col0;
#pragma unroll
                for (int bj = 0; bj < 2; ++bj) { f32x4 v0 = acc[ai][bj][m][0], v1 = acc[ai][bj][m][1];
                    if (act == 1) {
#pragma unroll
                        for (int j = 0; j < 4; ++j) { v0[j] = gelu_tanh_(v0[j]); v1[j] = gelu_tanh_(v1[j]); } }
                    else if (act == 2) {
#pragma unroll
                        for (int j = 0; j < 4; ++j) { v0[j] = sigmoidf_(v0[j]); v1[j] = sigmoidf_(v1[j]); } }
                    u32x4 w; w.x = cvt_pk_bf16(v0[0], v0[1]); w.y = cvt_pk_bf16(v0[2], v0[3]); w.z = cvt_pk_bf16(v1[0], v1[1]); w.w = cvt_pk_bf16(v1[2], v1[3]);
                    *(u32x4*)(rowp + bj * HALF) = w; } }
    }
};
template <int CTRL> __device__ __forceinline__ float dppz(float v) { return __builtin_bit_cast(float, __builtin_amdgcn_update_dpp(0, __builtin_bit_cast(int, v), CTRL, 0xF, 0xF, true)); }
__device__ __forceinline__ float row_prefix(float v) { v += dppz<0x111>(v); v += dppz<0x112>(v); v += dppz<0x114>(v); v += dppz<0x118>(v); return v; }
__device__ __forceinline__ float row_last(float v) { return __builtin_bit_cast(float, __builtin_amdgcn_update_dpp(0, __builtin_bit_cast(int, v), 0x15F, 0xF, 0xF, false)); }
__device__ __forceinline__ float row_total(float v) { v += dppz<0xB1>(v); v += dppz<0x4E>(v); v += dppz<0x141>(v); v += dppz<0x140>(v); return v; }
struct EpiGates {
    static constexpr bool PERM = false;
    const bf16* XC; bf16 *LAF, *BF, *LAB, *BB; const float *ba, *bx, *sp2; float* AGG;
    __device__ __forceinline__ void one_dir(const f32x4& ar, const f32x4& ag, const float* bap, const float* bxp, const float* spp, const u32x2 xw, bf16* LA, bf16* BO, float (&l)[4], float (&b)[4]) const {
        const f32x4 bav = *(const f32x4*)bap, bxv = *(const f32x4*)bxp, spv = *(const f32x4*)spp; const float xc[4] = {blo(xw.x), bhi(xw.x), blo(xw.y), bhi(xw.y)};
#pragma unroll
        for (int j = 0; j < 4; ++j) { const float r = sigmoidf_(ar[j] + bav[j]), ig = sigmoidf_(ag[j] + bxv[j]); const float l2 = -r * spv[j], av = fexp2(l2); l[j] = l2; b[j] = __builtin_amdgcn_sqrtf(fmaxf(1.0f - av * av, 0.f)) * ig * xc[j]; }
        u32x2 w; w.x = cvt_pk_bf16(l[0], l[1]); w.y = cvt_pk_bf16(l[2], l[3]); *(u32x2*)LA = w;
        w.x = cvt_pk_bf16(b[0], b[1]); w.y = cvt_pk_bf16(b[2], b[3]); *(u32x2*)BO = w;
        asm volatile("" ::: "memory");
    }
    template <bool FWD> __device__ __forceinline__ void agg_dir(const float (&la)[4][4], const float (&bb)[4][4], float* out, int fr) const {
        float A2[4], HE[4];
#pragma unroll
        for (int j = 0; j < 4; ++j) { float P[4], T[4];
#pragma unroll
            for (int m = 0; m < 4; ++m) { P[m] = row_prefix(la[m][j]); T[m] = row_last(P[m]); }
            A2[j] = (T[0] + T[1]) + (T[2] + T[3]); float acc = 0.f;
#pragma unroll
            for (int m = 0; m < 4; ++m) { float S;
                if (FWD) { float after = 0.f;
#pragma unroll
                    for (int q = m + 1; q < 4; ++q) after += T[q];
                    S = (T[m] - P[m]) + after; }
                else { float before = 0.f;
#pragma unroll
                    for (int q = 0; q < m; ++q) before += T[q];
                    S = (P[m] - la[m][j]) + before; }
                acc += bb[m][j] * fexp2(S); }
            HE[j] = row_prefix(acc); }
        if (fr == 15) { *(f32x4*)out = (f32x4){A2[0], A2[1], A2[2], A2[3]}; *(f32x4*)(out + D) = (f32x4){HE[0], HE[1], HE[2], HE[3]}; }
    }
    __device__ __forceinline__ void operator()(const f32x4 (&acc)[2][2][4][2], const Unit& u, int wr, int wc, int fr, int fq) const {
        const int row0 = u.pm * 256 + wr * 64 + fr, ch = u.pn * 64 + wc * 16 + fq * 4;
#pragma unroll
        for (int ai = 0; ai < 2; ++ai) { float laF[4][4], bF[4][4], laB[4][4], bB[4][4];
#pragma unroll
            for (int m = 0; m < 4; ++m) { const size_t ro = (size_t)(row0 + ai * HALF + m * 16) * D + ch;
                const u32x2 xw = *(const u32x2*)(XC + ro);
                one_dir(acc[ai][0][m][0], acc[ai][0][m][1], ba + ch, bx + ch, sp2 + ch, xw, LAF + ro, BF + ro, laF[m], bF[m]);
                one_dir(acc[ai][1][m][0], acc[ai][1][m][1], ba + 1024 + ch, bx + 1024 + ch, sp2 + 1024 + ch, xw, LAB + ro, BB + ro, laB[m], bB[m]); }
            const int sub = u.pm * 4 + ai * 2 + wr;
            agg_dir<true>(laF, bF, AGG + ((size_t)(sub * 2 + 0) * 2) * D + ch, fr);
            agg_dir<false>(laB, bB, AGG + ((size_t)(sub * 2 + 1) * 2) * D + ch, fr); }
    }
};
struct EpiPool {
    static constexpr bool PERM = true; bf16* O; const float* scale;
    __device__ __forceinline__ void operator()(const f32x4 (&acc)[2][2][4][2], const Unit& u, int wr, int wc, int fr, int fq) const {
        const int row0 = u.pm * 256 + wr * 64 + fr, col0 = u.pn * 256 + wc * 32 + 8 * fq;
        f32x4 sv[2][2];
#pragma unroll
        for (int bj = 0; bj < 2; ++bj)
#pragma unroll
            for (int n = 0; n < 2; ++n) sv[bj][n] = *(const f32x4*)(scale + col0 + bj * HALF + 4 * n);
#pragma unroll
        for (int ai = 0; ai < 2; ++ai)
#pragma unroll
            for (int m = 0; m < 4; ++m) { bf16* rowp = O + (size_t)(row0 + ai * HALF + m * 16) * D + col0;
#pragma unroll
                for (int bj = 0; bj < 2; ++bj) { const f32x4 v0 = acc[ai][bj][m][0] * sv[bj][0], v1 = acc[ai][bj][m][1] * sv[bj][1];
                    u32x4 w; w.x = cvt_pk_bf16(v0[0], v0[1]); w.y = cvt_pk_bf16(v0[2], v0[3]); w.z = cvt_pk_bf16(v1[0], v1[1]); w.w = cvt_pk_bf16(v1[2], v1[3]);
                    *(u32x4*)(rowp + bj * HALF) = w; } }
    }
};
struct EpiBranch {
    static constexpr bool PERM = true; bf16* O; const bf16* PROJ;
    __device__ __forceinline__ void operator()(const f32x4 (&acc)[2][2][4][2], const Unit& u, int wr, int wc, int fr, int fq) const {
        const int row0 = u.pm * 256 + wr * 64 + fr, col0 = u.pn * 256 + wc * 32 + 8 * fq; const int which = u.aux;
#pragma unroll
        for (int ai = 0; ai < 2; ++ai)
#pragma unroll
            for (int m = 0; m < 4; ++m) { const int r = row0 + ai * HALF + m * 16; bf16* rowp = O + (size_t)r * D + col0; const bf16* sp = PROJ + (size_t)r * INC + 3072 + which * 1024 + col0;
#pragma unroll
                for (int bj = 0; bj < 2; ++bj) { const u32x4 s = *(const u32x4*)(sp + bj * HALF); const f32x4 a0 = acc[ai][bj][m][0], a1 = acc[ai][bj][m][1];
                    float o[8] = {blo(s.x) * a0[0], bhi(s.x) * a0[1], blo(s.y) * a0[2], bhi(s.y) * a0[3], blo(s.z) * a1[0], bhi(s.z) * a1[1], blo(s.w) * a1[2], bhi(s.w) * a1[3]};
                    if (which) { const u32x4 p = *(const u32x4*)(rowp + bj * HALF); o[0] += blo(p.x); o[1] += bhi(p.x); o[2] += blo(p.y); o[3] += bhi(p.y); o[4] += blo(p.z); o[5] += bhi(p.z); o[6] += blo(p.w); o[7] += bhi(p.w); }
                    u32x4 w; w.x = cvt_pk_bf16(o[0], o[1]); w.y = cvt_pk_bf16(o[2], o[3]); w.z = cvt_pk_bf16(o[4], o[5]); w.w = cvt_pk_bf16(o[6], o[7]);
                    *(u32x4*)(rowp + bj * HALF) = w; } }
    }
};
struct EpiOut {
    static constexpr bool PERM = true; bf16* C;
    __device__ __forceinline__ void operator()(const f32x4 (&acc)[2][2][4][2], const Unit& u, int wr, int wc, int fr, int fq) const {
        const int row0 = u.pm * 256 + wr * 64 + fr, col0 = u.pn * 256 + wc * 32 + 8 * fq;
#pragma unroll
        for (int ai = 0; ai < 2; ++ai)
#pragma unroll
            for (int m = 0; m < 4; ++m) { bf16* rowp = C + (size_t)(row0 + ai * HALF + m * 16) * D + col0;
#pragma unroll
                for (int bj = 0; bj < 2; ++bj) { const f32x4 v0 = acc[ai][bj][m][0], v1 = acc[ai][bj][m][1];
                    u32x4 w; w.x = cvt_pk_bf16(v0[0], v0[1]); w.y = cvt_pk_bf16(v0[2], v0[3]); w.z = cvt_pk_bf16(v1[0], v1[1]); w.w = cvt_pk_bf16(v1[2], v1[3]);
                    *(u32x4*)(rowp + bj * HALF) = w; } }
    }
};
struct EpiMoe1 {
    static constexpr bool PERM = true; unsigned char* O; const float* b1;
    __device__ __forceinline__ void operator()(const f32x4 (&acc)[2][2][4][2], const Unit& u, int wr, int wc, int fr, int fq) const {
        const int row0 = u.pm * 256 + wr * 64 + fr, j0 = u.pn * 128 + wc * 32 + 8 * fq; const float* bp = b1 + (size_t)u.aux * 2048 + j0;
        const f32x4 bg0 = *(const f32x4*)(bp), bg1 = *(const f32x4*)(bp + 4), bl0 = *(const f32x4*)(bp + 1024), bl1 = *(const f32x4*)(bp + 1028);
#pragma unroll
        for (int ai = 0; ai < 2; ++ai)
#pragma unroll
            for (int m = 0; m < 4; ++m) { unsigned char* rowp = O + (size_t)(row0 + ai * HALF + m * 16) * D + j0;
                const f32x4 g0 = acc[ai][0][m][0] + bg0, g1 = acc[ai][0][m][1] + bg1, l0 = acc[ai][1][m][0] + bl0, l1 = acc[ai][1][m][1] + bl1;
                float o[8];
#pragma unroll
                for (int j = 0; j < 4; ++j) { const float ga = fminf(g0[j], 7.0f), la = fminf(fmaxf(l0[j], -7.0f), 7.0f); o[j] = (ga * frcp(1.0f + fexp2(ga * (-1.702f * LOG2E)))) * __builtin_fmaf(la, ACT8SCALE, ACT8SCALE);
                    const float gb = fminf(g1[j], 7.0f), lb = fminf(fmaxf(l1[j], -7.0f), 7.0f); o[4 + j] = (gb * frcp(1.0f + fexp2(gb * (-1.702f * LOG2E)))) * __builtin_fmaf(lb, ACT8SCALE, ACT8SCALE); }
                int w0 = __builtin_amdgcn_cvt_pk_fp8_f32(o[0], o[1], 0, false); w0 = __builtin_amdgcn_cvt_pk_fp8_f32(o[2], o[3], w0, true);
                int w1 = __builtin_amdgcn_cvt_pk_fp8_f32(o[4], o[5], 0, false); w1 = __builtin_amdgcn_cvt_pk_fp8_f32(o[6], o[7], w1, true);
                *(u32x2*)rowp = (u32x2){(unsigned)w0, (unsigned)w1}; }
    }
};
struct EpiMoe2 {
    static constexpr bool PERM = true; unsigned char* O; const float* b2;
    __device__ __forceinline__ void operator()(const f32x4 (&acc)[2][2][4][2], const Unit& u, int wr, int wc, int fr, int fq) const {
        const int row0 = u.pm * 256 + wr * 64 + fr, col0 = u.pn * 256 + wc * 32 + 8 * fq; const float* bp = b2 + (size_t)u.aux * 1024 + col0;
        f32x4 bv[2][2];
#pragma unroll
        for (int bj = 0; bj < 2; ++bj)
#pragma unroll
            for (int n = 0; n < 2; ++n) bv[bj][n] = *(const f32x4*)(bp + bj * HALF + 4 * n);
#pragma unroll
        for (int ai = 0; ai < 2; ++ai)
#pragma unroll
            for (int m = 0; m < 4; ++m) { unsigned char* rowp = O + (size_t)(row0 + ai * HALF + m * 16) * D + col0;
#pragma unroll
                for (int bj = 0; bj < 2; ++bj) { const f32x4 v0 = (acc[ai][bj][m][0] + bv[bj][0]) * O8SCALE, v1 = (acc[ai][bj][m][1] + bv[bj][1]) * O8SCALE;
                    int w0 = __builtin_amdgcn_cvt_pk_fp8_f32(v0[0], v0[1], 0, false); w0 = __builtin_amdgcn_cvt_pk_fp8_f32(v0[2], v0[3], w0, true);
                    int w1 = __builtin_amdgcn_cvt_pk_fp8_f32(v1[0], v1[1], 0, false); w1 = __builtin_amdgcn_cvt_pk_fp8_f32(v1[2], v1[3], w1, true);
                    *(u32x2*)(rowp + bj * HALF) = (u32x2){(unsigned)w0, (unsigned)w1}; } }
    }
};

constexpr int NPHASE = 15;
__global__ void __launch_bounds__(512, 2) mk_fwd(Args a) {
    extern __shared__ __attribute__((aligned(16))) unsigned char lds_raw[];
    Frame F; F.lds = (LAS unsigned char*)lds_raw; F.tid = threadIdx.x; F.lane = F.tid & 63; F.wave = __builtin_amdgcn_readfirstlane(F.tid >> 6); F.G = gridDim.x; F.blk = blockIdx.x;
    volatile LAS unsigned* MISC = (volatile LAS unsigned*)(F.lds + LDS_MISC);
    if (F.tid < 64) MISC[F.tid] = 0u;
    __syncthreads();
    unsigned char* ws = a.ws;
#if MK_MULTI
#define GRID_BAR() do { } while (0)
#else
    XcdBarrier bar = xcd_barrier_post((unsigned*)(ws + WS_CTL) + CW_BAR, MISC + 8);
#define GRID_BAR() xcd_barrier(bar)
#endif
    const int lo = a.ph_lo, hi = a.ph_hi;
#define IN(k) (lo <= (k) && (k) < hi)
#define SEAM(k) do { if (IN((k) + 1)) GRID_BAR(); } while (0)
    LAS unsigned char* ring = F.lds;

#ifndef DUPMASK
#define DUPMASK 0
#endif
#define DUP(k) ((DUPMASK >> (k)) & 1)
#define RUN(k, BODY) do { if (IN(k)) { BODY; if (DUP(k)) { GRID_BAR(); BODY; } SEAM(k); } } while (0)
#define PH0 p0_prologue(F, a)
#define PH1 p1_prenorm(F, a)
#define PH2 do { ctx_proj_mini(F, a); pg8::Gemm g{(const bf16*)(ws + WS_U), (const bf16*)(ws + WS_WIN), D, D, D}; OrdProj S{F.G, F.blk}; EpiProj E{(bf16*)(ws + WS_PROJ)}; \
        pg8::gemm_phase<EpiProj, OrdProj>(ring, g, S, E); } while (0)
#define PH3 p3_conv_pool(F, a)
#define PH4 do { \
        { pg8::Gemm g{(const bf16*)(ws + WS_XC), (const bf16*)(ws + WS_WG), D, 256, 256}; OrdGates S{F.G, F.blk}; \
          EpiGates E{(const bf16*)(ws + WS_XC), (bf16*)(ws + WS_LAF), (bf16*)(ws + WS_BF), (bf16*)(ws + WS_LAB), (bf16*)(ws + WS_BB), a.in[I_BA], a.in[I_BX], (const float*)(ws + WS_SP2), (float*)(ws + WS_AGG)}; \
          pg8::gemm_phase<EpiGates, OrdGates>(ring, g, S, E); } \
        { pg8::Gemm g{(const bf16*)(ws + WS_DP), (const bf16*)(ws + WS_WP), D, 256, 256}; OrdPool S{F.G, F.blk}; EpiPool E{(bf16*)(ws + WS_YY) + (size_t)ML * D, a.in[I_POOLS]}; \
          pg8::gemm_phase<EpiPool, OrdPool>(ring, g, S, E); } } while (0)
#define PH6 p6_carry(F, a)
#define PH7 p7_scan_out(F, a)
#define PH8 do { pg8::Gemm g{(const bf16*)(ws + WS_YY), (const bf16*)(ws + WS_WPROJ), D, D, D}; OrdBranch S{F.G, F.blk}; EpiBranch E{(bf16*)(ws + WS_MERGED), (const bf16*)(ws + WS_PROJ)}; \
        pg8::gemm_phase<EpiBranch, OrdBranch>(ring, g, S, E); } while (0)
#define PH9 do { pg8::Gemm g{(const bf16*)(ws + WS_MERGED), (const bf16*)(ws + WS_WOUT), D, D, D}; OrdOut S{F.G, F.blk}; EpiOut E{(bf16*)(ws + WS_MLAT)}; \
        pg8::gemm_phase<EpiOut, OrdOut>(ring, g, S, E); } while (0)
#define PH10 p10_post_mix_route(F, a)
#define PH12 do { build_tile_table(F, a); const LAS int* tab = (const LAS int*)(F.lds + LDS_TAB); \
        pg8::Gemm g{(const bf16*)(ws + WS_VB), (const bf16*)(ws + WS_W1T), D, D, D}; OrdMoe<8, true> S{F.G, F.blk, tab, __builtin_amdgcn_readfirstlane(tab[300])}; EpiMoe1 E{(unsigned char*)(ws + WS_ACT), a.in[I_B1]}; \
        pg8::gemm_phase8<EpiMoe1, OrdMoe<8, true>, true>(ring, g, S, E, SC_ONE, SC_W8, (const int*)(ws + WS_TOKL)); } while (0)
#define PH13 do { build_tile_table(F, a); const LAS int* tab = (const LAS int*)(F.lds + LDS_TAB); \
        pg8::Gemm g{(const bf16*)(ws + WS_ACT), (const bf16*)(ws + WS_W2T), D, D, D}; OrdMoe<4, false> S{F.G, F.blk, tab, __builtin_amdgcn_readfirstlane(tab[300])}; EpiMoe2 E{(unsigned char*)(ws + WS_APERM), a.in[I_B2]}; \
        pg8::gemm_phase8<EpiMoe2, OrdMoe<4, false>>(ring, g, S, E, SC_ACT8, SC_W8); } while (0)
#define PH14 do { build_tile_table(F, a); p14_final(F, a); } while (0)
#ifndef BARX
#define BARX 0
#endif
    if (IN(0)) { PH0; }
    RUN(1, PH1); RUN(2, PH2); RUN(3, PH3); RUN(4, PH4); RUN(6, PH6); RUN(7, PH7);
    RUN(8, PH8); RUN(9, PH9);
    if (IN(10)) { const int nrep10 = DUP(10) ? 2 : 1;
#pragma nounroll
        for (int rep = 0; rep < nrep10; ++rep) { if (rep) GRID_BAR(); p10_post_mix_route(F, a, rep); } SEAM(10); }
 RUN(12, PH12); RUN(13, PH13);
    if (IN(14)) { PH14; if (DUP(14)) { GRID_BAR(); PH14; } }
#undef IN
#undef SEAM
}

extern "C" void kernel_launch(void* const* d_in, const int* in_sizes, int n_in, void* d_out, int out_size, void* d_ws, size_t ws_size, hipStream_t stream) {
    static int grid = 0;
    if (grid == 0) {
        if (n_in != 29 || out_size != ML * D || ws_size < WS_END) { fprintf(stderr, "kernel_launch: unexpected shapes (n_in %d out %d ws %zu)\n", n_in, out_size, ws_size); grid = -1; return; }
        int dev = 0, cus = 0, per_cu = 0;
        if (hipGetDevice(&dev) != hipSuccess || hipDeviceGetAttribute(&cus, hipDeviceAttributeMultiprocessorCount, dev) != hipSuccess) { grid = -1; return; }
        if (hipFuncSetAttribute((const void*)mk_fwd, hipFuncAttributeMaxDynamicSharedMemorySize, LDS_BYTES) != hipSuccess) { fprintf(stderr, "kernel_launch: hipFuncSetAttribute failed\n"); grid = -1; return; }
        if (hipOccupancyMaxActiveBlocksPerMultiprocessor(&per_cu, (const void*)mk_fwd, 512, LDS_BYTES) != hipSuccess || per_cu < 1) { fprintf(stderr, "kernel_launch: occupancy query says %d\n", per_cu); }
        (void)hipGetLastError();
        grid = cus < 256 ? cus : 256;
    }
    if (grid < 0) return;
    (void)hipMemsetAsync((char*)d_ws + WS_CTL, 0, CTL_ZERO_BYTES, stream);
    Args a{};
    for (int i = 0; i < 29; ++i) a.in[i] = (const float*)d_in[i];
    a.out = (float*)d_out; a.ws = (unsigned char*)d_ws;
#if MK_MULTI
    for (int p = 0; p < NPHASE; ++p) { a.ph_lo = p; a.ph_hi = p + 1; hipLaunchKernelGGL(mk_fwd, dim3(grid), dim3(512), LDS_BYTES, stream, a); }
#else
    a.ph_lo = 0; a.ph_hi = NPHASE;
    hipLaunchKernelGGL(mk_fwd, dim3(grid), dim3(512), LDS_BYTES, stream, a);
#endif
}
```
